# Optimizing an MI355X kernel written in HIP

```python
import jax, jax.numpy as jnp
from jax import lax
import numpy as np

D_MODEL = 1024
BATCH = 16
SEQ = 2048
DEPTH = 1

HEAD_DIM = 64
ROPE_DIM = HEAD_DIM // 4
ROPE_THETA = 500000.0
Q_BLOCK = 128
EPS = 1e-6
NEG_INF = -1e30
FORCED_SCORE = 1e6
NSA_HEADS = 8
NSA_KV_HEADS = 2
NSA_GROUP = NSA_HEADS // NSA_KV_HEADS
CMP_LEN = 32
CMP_STRIDE = 16
CMP_HIDDEN = 128
SLC_BLOCK = 64
SLC_TOPN = 8
WINDOW = 512
DSA_HEADS = 8
KV_LORA = 128
NOPE_DIM = HEAD_DIM - ROPE_DIM
IDX_HEADS = 8
IDX_DIM = 64
IDX_TOPK_MAX = 256
D_FF = ((8 * D_MODEL + 3 * 256 - 1) // (3 * 256)) * 256
IN_SPLITS = (NSA_HEADS * HEAD_DIM,) + (NSA_KV_HEADS * HEAD_DIM,) * 6 + (
    3 * NSA_HEADS, DSA_HEADS * HEAD_DIM, KV_LORA, ROPE_DIM, IDX_HEADS * IDX_DIM, IDX_DIM, IDX_HEADS)
IN_WIDTH = sum(IN_SPLITS)

kernel_name = 'hybrid_nsa_dsa_parallel_heads'


def _rms_norm(x, g):
    xf = x.astype(jnp.float32)
    y = xf * lax.rsqrt(jnp.mean(xf * xf, axis=-1, keepdims=True) + EPS)
    return (y * g.astype(jnp.float32)).astype(x.dtype)


def _rope_tables(seq):
    inv_freq = 1.0 / (ROPE_THETA ** (jnp.arange(0, ROPE_DIM, 2, dtype=jnp.float32) / ROPE_DIM))
    ang = jnp.arange(seq, dtype=jnp.float32)[:, None] * inv_freq[None, :]
    return jnp.cos(ang), jnp.sin(ang)


def _rope(x, cos, sin):
    half = ROPE_DIM // 2
    xr = x[..., :ROPE_DIM].astype(jnp.float32)
    x1, x2 = xr[..., :half], xr[..., half:]
    c, s = cos[:, None, :], sin[:, None, :]
    rot = jnp.concatenate([x1 * c - x2 * s, x2 * c + x1 * s], axis=-1)
    return jnp.concatenate([rot.astype(x.dtype), x[..., ROPE_DIM:]], axis=-1)


def _masked_softmax(s, mask):
    s = jnp.where(mask, s.astype(jnp.float32), NEG_INF)
    m = jnp.max(s, axis=-1, keepdims=True)
    e = jnp.where(mask, jnp.exp(s - m), 0.0)
    return e / jnp.maximum(jnp.sum(e, axis=-1, keepdims=True), 1e-30)


def _q_blocks(a):
    b, s = a.shape[:2]
    return jnp.moveaxis(a.reshape((b, s // Q_BLOCK, Q_BLOCK) + a.shape[2:]), 1, 0)


def _from_blocks(o):
    nb, b, tq = o.shape[:3]
    return jnp.moveaxis(o, 0, 1).reshape((b, nb * tq) + o.shape[3:])


def _compress(k, pe, w1, b1, w2, b2):
    b, s, g, dh = k.shape
    n_cmp = (s - CMP_LEN) // CMP_STRIDE + 1
    idx = np.arange(n_cmp)[:, None] * CMP_STRIDE + np.arange(CMP_LEN)[None, :]
    blocks = k[:, idx] + pe[:, None, :]
    flat = jnp.transpose(blocks, (0, 3, 1, 2, 4)).reshape(b, g, n_cmp, CMP_LEN * dh)
    hid = jax.nn.gelu(flat @ w1 + b1)
    return hid @ w2 + b2


def _nsa_group(q, k_cmp, v_cmp, k_slc, v_slc, k_win, v_win, gates, cos, sin,
               cmp_pe, cmp_w1, cmp_b1, cmp_w2, cmp_b2):
    b, s = q.shape[:2]
    g_, r_, dh = NSA_KV_HEADS, NSA_GROUP, HEAD_DIM
    scale = HEAD_DIM ** -0.5
    tpos = jnp.arange(s)
    qg = _rope(q.reshape(b, s, NSA_HEADS, dh), cos, sin).reshape(b, s, g_, r_, dh)
    kc = _compress(_rope(k_cmp.reshape(b, s, g_, dh), cos, sin), cmp_pe[0], cmp_w1[0], cmp_b1[0], cmp_w2[0], cmp_b2[0])
    vc = _compress(v_cmp.reshape(b, s, g_, dh), cmp_pe[1], cmp_w1[1], cmp_b1[1], cmp_w2[1], cmp_b2[1])
    n_cmp = kc.shape[2]
    cmp_end = jnp.arange(n_cmp) * CMP_STRIDE + CMP_LEN - 1
    mask_c = cmp_end[None, :] <= tpos[:, None]
    p_c = _masked_softmax(jnp.einsum('bsgrd,bgnd->bgrsn', qg, kc) * scale, mask_c)
    o_cmp = jnp.einsum('bgrsn,bgnd->bsgrd', p_c.astype(vc.dtype), vc).reshape(b, s, NSA_HEADS, dh)
    n_slc = s // SLC_BLOCK
    ci = np.arange(n_cmp)[:, None] * CMP_STRIDE
    sj = np.arange(n_slc)[None, :] * SLC_BLOCK
    overlap = ((ci < sj + SLC_BLOCK) & (ci + CMP_LEN > sj)).astype(np.float32)
    imp = jnp.einsum('bgrsn,nj->bgsj', p_c, jnp.asarray(overlap))
    blk_t = (tpos // SLC_BLOCK)[:, None]
    j = jnp.arange(n_slc)[None, :]
    visible = j <= blk_t
    forced = (j == 0) | (j == blk_t) | (j == blk_t - 1)
    imp = jnp.where(visible, jnp.where(forced, FORCED_SCORE, imp), -jnp.inf)
    n_sel = min(SLC_TOPN, n_slc)
    _, sel = lax.top_k(imp, n_sel)
    ks_blocks = jnp.transpose(_rope(k_slc.reshape(b, s, g_, dh), cos, sin).reshape(b, n_slc, SLC_BLOCK, g_, dh), (0, 3, 1, 2, 4))
    vs_blocks = jnp.transpose(v_slc.reshape(b, n_slc, SLC_BLOCK, g_, dh), (0, 3, 1, 2, 4))
    pad = ((0, 0), (WINDOW, 0), (0, 0), (0, 0))
    kw = jnp.pad(_rope(k_win.reshape(b, s, g_, dh), cos, sin), pad)
    vw = jnp.pad(v_win.reshape(b, s, g_, dh), pad)
    gather = jax.vmap(jax.vmap(lambda tab, ix: tab[ix]))

    def block_fn(args):
        q_b, sel_b, t0 = args
        sel_b = jnp.transpose(sel_b, (0, 2, 1, 3))
        tq = t0 + jnp.arange(Q_BLOCK)
        kg = gather(ks_blocks, sel_b).reshape(b, g_, Q_BLOCK, n_sel * SLC_BLOCK, dh)
        vg = gather(vs_blocks, sel_b).reshape(b, g_, Q_BLOCK, n_sel * SLC_BLOCK, dh)
        kpos = (sel_b[..., None] * SLC_BLOCK + jnp.arange(SLC_BLOCK)).reshape(b, g_, Q_BLOCK, n_sel * SLC_BLOCK)
        mask_s = (kpos <= tq[None, None, :, None])[:, :, None]
        p_s = _masked_softmax(jnp.einsum('btgrd,bgtkd->bgrtk', q_b, kg) * scale, mask_s)
        o_s = jnp.einsum('bgrtk,bgtkd->btgrd', p_s.astype(vg.dtype), vg)
        kwb = lax.dynamic_slice_in_dim(kw, t0, Q_BLOCK + WINDOW, axis=1)
        vwb = lax.dynamic_slice_in_dim(vw, t0, Q_BLOCK + WINDOW, axis=1)
        wpos = t0 - WINDOW + jnp.arange(Q_BLOCK + WINDOW)
        mask_w = (wpos[None, :] <= tq[:, None]) & (wpos[None, :] > tq[:, None] - WINDOW) & (wpos[None, :] >= 0)
        p_w = _masked_softmax(jnp.einsum('btgrd,bsgd->bgrts', q_b, kwb) * scale, mask_w)
        o_w = jnp.einsum('bgrts,bsgd->btgrd', p_w.astype(vwb.dtype), vwb)
        return o_s, o_w

    starts = jnp.arange(s // Q_BLOCK, dtype=jnp.int32) * Q_BLOCK
    o_s, o_w = lax.map(block_fn, (_q_blocks(qg), _q_blocks(jnp.transpose(sel, (0, 2, 1, 3))), starts))
    o_s = _from_blocks(o_s).reshape(b, s, NSA_HEADS, dh)
    o_w = _from_blocks(o_w).reshape(b, s, NSA_HEADS, dh)
    gt = jax.nn.sigmoid(gates.astype(jnp.float32)).astype(q.dtype).reshape(b, s, 3, NSA_HEADS, 1)
    o = gt[:, :, 0] * o_cmp + gt[:, :, 1] * o_s + gt[:, :, 2] * o_w
    return o.reshape(b, s, NSA_HEADS * dh)


def _dsa_group(q, c_kv, k_rope, q_idx, k_idx, w_idx, cos, sin, g_kv, w_uk, w_uv):
    b, s = q.shape[:2]
    scale = HEAD_DIM ** -0.5
    q = _rope(q.reshape(b, s, DSA_HEADS, HEAD_DIM), cos, sin)
    q_rope, q_nope = q[..., :ROPE_DIM], q[..., ROPE_DIM:]
    c_kv = _rms_norm(c_kv, g_kv)
    k_rope = _rope(k_rope[:, :, None, :], cos, sin)[:, :, 0]
    q_lat = jnp.einsum('bshe,hre->bshr', q_nope, w_uk)
    q_idx = _rope(q_idx.reshape(b, s, IDX_HEADS, IDX_DIM), cos, sin)
    k_idx = _rope(k_idx[:, :, None, :], cos, sin)[:, :, 0]
    w_idx = w_idx.astype(jnp.float32) * (IDX_HEADS ** -0.5 * IDX_DIM ** -0.5)
    k_sel = min(IDX_TOPK_MAX, s // 4)
    spos = jnp.arange(s)
    gather = jax.vmap(lambda tab, ix: tab[ix])

    def block_fn(args):
        ql_b, qr_b, qi_b, wi_b, t0 = args
        tq = t0 + jnp.arange(Q_BLOCK)
        logits = jnp.einsum('bthd,bsd->bths', qi_b, k_idx).astype(jnp.float32)
        score = jnp.einsum('bths,bth->bts', jax.nn.relu(logits), wi_b)
        score = jnp.where(spos[None, None, :] <= tq[None, :, None], score, -jnp.inf)
        _, idx = lax.top_k(score, k_sel)
        cg = gather(c_kv, idx)
        krg = gather(k_rope, idx)
        sc = (jnp.einsum('bthr,btkr->bhtk', ql_b, cg) + jnp.einsum('bthe,btke->bhtk', qr_b, krg)) * scale
        mask = (idx <= tq[None, :, None])[:, None]
        p = _masked_softmax(sc, mask)
        return jnp.einsum('bhtk,btkr->bthr', p.astype(cg.dtype), cg)

    starts = jnp.arange(s // Q_BLOCK, dtype=jnp.int32) * Q_BLOCK
    o_lat = _from_blocks(lax.map(block_fn, (_q_blocks(q_lat), _q_blocks(q_rope), _q_blocks(q_idx), _q_blocks(w_idx), starts)))
    o = jnp.einsum('bshr,hrd->bshd', o_lat, w_uv)
    return o.reshape(b, s, DSA_HEADS * HEAD_DIM)


def _hybrid_mixer(h, cos, sin, w_in, cmp_pe, cmp_w1, cmp_b1, cmp_w2, cmp_b2, g_kv, w_uk, w_uv, w_out):
    proj = h @ w_in
    split_points = [int(v) for v in np.cumsum(IN_SPLITS)[:-1]]
    (nq, nkc, nvc, nks, nvs, nkw, nvw, ngate, dq, dckv, dkr, iq, ik, iw) = jnp.split(proj, split_points, axis=-1)
    o_a = _nsa_group(nq, nkc, nvc, nks, nvs, nkw, nvw, ngate, cos, sin, cmp_pe, cmp_w1, cmp_b1, cmp_w2, cmp_b2)
    o_b = _dsa_group(dq, dckv, dkr, iq, ik, iw, cos, sin, g_kv, w_uk, w_uv)
    return jnp.concatenate([o_a, o_b], axis=-1) @ w_out


def _swiglu(h, w_gate_up, w_down):
    gate, up = jnp.split(h @ w_gate_up, 2, axis=-1)
    return (jax.nn.silu(gate) * up) @ w_down


def setup_inputs(seed: int = 0) -> dict:
    key = jax.random.key(seed)
    ks = jax.random.split(key, 20)
    L = DEPTH

    def nrm(k, shape, scale):
        return jax.random.normal(k, shape, jnp.float32) * scale

    def gain(k, shape):
        return 1.0 + 0.05 * jax.random.normal(k, shape, jnp.float32)

    return {
        'x': nrm(ks[0], (BATCH, SEQ, D_MODEL), 1.0),
        'c': nrm(ks[1], (BATCH, D_MODEL), 1.0),
        'w_ada': nrm(ks[2], (L, D_MODEL, 6 * D_MODEL), 0.5 * D_MODEL ** -0.5),
        'b_ada': nrm(ks[3], (L, 6 * D_MODEL), 0.01),
        'g_pre_mix': gain(ks[4], (L, D_MODEL)),
        'g_post_mix': gain(ks[5], (L, D_MODEL)),
        'g_pre_ffn': gain(ks[6], (L, D_MODEL)),
        'g_post_ffn': gain(ks[7], (L, D_MODEL)),
        'w_in': nrm(ks[8], (L, D_MODEL, IN_WIDTH), D_MODEL ** -0.5),
        'cmp_pe': nrm(ks[9], (L, 2, CMP_LEN, HEAD_DIM), 0.1),
        'cmp_w1': nrm(ks[10], (L, 2, CMP_LEN * HEAD_DIM, CMP_HIDDEN), (CMP_LEN * HEAD_DIM) ** -0.5),
        'cmp_b1': nrm(ks[11], (L, 2, CMP_HIDDEN), 0.01),
        'cmp_w2': nrm(ks[12], (L, 2, CMP_HIDDEN, HEAD_DIM), CMP_HIDDEN ** -0.5),
        'cmp_b2': nrm(ks[13], (L, 2, HEAD_DIM), 0.01),
        'g_kv_norm': gain(ks[14], (L, KV_LORA)),
        'w_uk': nrm(ks[15], (L, DSA_HEADS, KV_LORA, NOPE_DIM), KV_LORA ** -0.5),
        'w_uv': nrm(ks[16], (L, DSA_HEADS, KV_LORA, HEAD_DIM), KV_LORA ** -0.5),
        'w_out': nrm(ks[17], (L, D_MODEL, D_MODEL), D_MODEL ** -0.5),
        'w_gate_up': nrm(ks[18], (L, D_MODEL, 2 * D_FF), D_MODEL ** -0.5),
        'w_down': nrm(ks[19], (L, D_FF, D_MODEL), D_FF ** -0.5),
    }


def reference(x, c, w_ada, b_ada, g_pre_mix, g_post_mix, g_pre_ffn, g_post_ffn, w_in,
              cmp_pe, cmp_w1, cmp_b1, cmp_w2, cmp_b2, g_kv_norm, w_uk, w_uv, w_out,
              w_gate_up, w_down):
    cos, sin = _rope_tables(x.shape[1])
    c_act = jax.nn.silu(c)
    for l in range(DEPTH):
        mod = (c_act @ w_ada[l] + b_ada[l])[:, None, :]
        sh_m, sc_m, ga_m, sh_f, sc_f, ga_f = jnp.split(mod, 6, axis=-1)
        h = _rms_norm(x, g_pre_mix[l]) * (1.0 + sc_m) + sh_m
        y = _hybrid_mixer(h, cos, sin, w_in[l], cmp_pe[l], cmp_w1[l], cmp_b1[l], cmp_w2[l], cmp_b2[l],
                          g_kv_norm[l], w_uk[l], w_uv[l], w_out[l])
        x = x + ga_m * _rms_norm(y, g_post_mix[l])
        h = _rms_norm(x, g_pre_ffn[l]) * (1.0 + sc_f) + sh_f
        x = x + ga_f * _rms_norm(_swiglu(h, w_gate_up[l], w_down[l]), g_post_ffn[l])
    return x
```

```cpp
#include <hip/hip_runtime.h>
#include <cstdio>
#include <cstdint>

#define LAS __attribute__((address_space(3)))
#define GAS __attribute__((address_space(1)))
typedef unsigned short bf16_t;
typedef short bf16x8 __attribute__((ext_vector_type(8)));
typedef short s16x4 __attribute__((ext_vector_type(4)));
typedef float f32x2 __attribute__((ext_vector_type(2)));
typedef float f32x4 __attribute__((ext_vector_type(4)));
typedef float f32x16 __attribute__((ext_vector_type(16)));
typedef unsigned u32x2 __attribute__((ext_vector_type(2)));
typedef unsigned u32x4 __attribute__((ext_vector_type(4)));
typedef unsigned long long u64;

#ifndef MK_N_LAUNCHES
#define MK_N_LAUNCHES 1
#endif

constexpr int NB = 16, SEQ = 2048, DM = 1024, MTOK = NB * SEQ;
constexpr int NPROJ = 2560, DFF = 2816, NGU = 2 * DFF;
constexpr float EPS = 1e-6f;
constexpr float C2 = 0.125f * 1.4426950408889634f;
constexpr float NEGBIG = -1e30f;
constexpr int NPH = 11;

constexpr size_t MiB = 1u << 20;
constexpr size_t WS_CTL = 0, CTL_ZERO_BYTES = 1 * MiB;
constexpr size_t WS_ROPE = 1 * MiB;
constexpr size_t WS_MOD = WS_ROPE + 128 * 1024;
constexpr size_t WS_B1P = WS_MOD + 384 * 1024;
constexpr size_t WS_B1PP = WS_B1P + 2048;
constexpr size_t WS_WIN = 2 * MiB, WS_WOUT = 7 * MiB, WS_WGU = 9 * MiB, WS_WDN = 20 * MiB, WS_WKV = 26 * MiB, WS_WC1 = 27 * MiB, WS_WC2 = 29 * MiB;
constexpr size_t WS_HID = 30 * MiB;
constexpr size_t WS_KC = 34 * MiB;
constexpr size_t WS_VCT = 34 * MiB + 512 * 1024;
constexpr size_t WS_SSQC = 35 * MiB;
constexpr size_t WS_BM = 35 * MiB + 512 * 1024;
constexpr size_t WS_SSQY = 36 * MiB;
constexpr size_t WS_H = 40 * MiB, WS_Y = 104 * MiB, WS_AO = 168 * MiB, WS_R4 = 232 * MiB;
constexpr size_t WS_QN = WS_R4, WS_QD = WS_R4 + 32 * MiB, WS_QI = WS_R4 + 64 * MiB, WS_KD = WS_R4 + 96 * MiB, WS_VD = WS_R4 + 128 * MiB, WS_OCMP = WS_R4 + 160 * MiB;
constexpr size_t WS_KCR = WS_R4 + 192 * MiB;
constexpr size_t PLANE_BUF = 8 * MiB;
constexpr size_t WS_CRAW = WS_R4 + 240 * MiB;
constexpr size_t WS_KI = WS_R4 + 256 * MiB, WS_KR = WS_R4 + 260 * MiB, WS_GT = WS_R4 + 261 * MiB, WS_WI = WS_R4 + 264 * MiB, WS_MASKD = WS_R4 + 265 * MiB;
constexpr size_t WS_ACT = WS_R4;
constexpr size_t WS_Z = WS_AO;
constexpr size_t WS_SSQZ = 506 * MiB;
constexpr size_t WS_END = 510 * MiB;
constexpr int CW_BAR = 4096;
constexpr int CW_Q_IDX = 64, CW_Q_FLASH = 128;

constexpr int LDS_BYTES = 147456;
constexpr int MISC_OFF = LDS_BYTES - 256;

__device__ __forceinline__ unsigned cvt_pk_bf16(float lo, float hi) { unsigned r; asm volatile("v_cvt_pk_bf16_f32 %0, %1, %2" : "=v"(r) : "v"(lo), "v"(hi)); return r; }
__device__ __forceinline__ float bf2f(unsigned short h) { return __uint_as_float(((unsigned)h) << 16); }
__device__ __forceinline__ float bflo(unsigned w) { return __uint_as_float(w << 16); }
__device__ __forceinline__ float bfhi(unsigned w) { return __uint_as_float(w & 0xffff0000u); }
__device__ __forceinline__ u32x4 pack8(const float (&v)[8]) { u32x4 w; w.x = cvt_pk_bf16(v[0], v[1]); w.y = cvt_pk_bf16(v[2], v[3]); w.z = cvt_pk_bf16(v[4], v[5]); w.w = cvt_pk_bf16(v[6], v[7]); return w; }
__device__ __forceinline__ float fast_rcp(float x) { return __builtin_amdgcn_rcpf(x); }
__device__ __forceinline__ float fast_exp2(float x) { return __builtin_amdgcn_exp2f(x); }
__device__ __forceinline__ float swap_max(float v) { auto rr = __builtin_amdgcn_permlane32_swap(__float_as_uint(v), __float_as_uint(v), false, false); return fmaxf(__uint_as_float(rr[0]), __uint_as_float(rr[1])); }
__device__ __forceinline__ float swap_sum(float v) { auto rr = __builtin_amdgcn_permlane32_swap(__float_as_uint(v), __float_as_uint(v), false, false); return __uint_as_float(rr[0]) + __uint_as_float(rr[1]); }
__device__ __forceinline__ float max3f(float a, float b, float c) { float r; asm("v_max3_f32 %0, %1, %2, %3" : "=v"(r) : "v"(a), "v"(b), "v"(c)); return r; }
__device__ __forceinline__ float quad_xor1(float x) { return __int_as_float(__builtin_amdgcn_update_dpp(0, __float_as_int(x), 0xB1, 0xF, 0xF, true)); }
__device__ __forceinline__ float quad_xor2(float x) { return __int_as_float(__builtin_amdgcn_update_dpp(0, __float_as_int(x), 0x4E, 0xF, 0xF, true)); }
__device__ __forceinline__ float relu1(float x) { float r; asm("v_max_f32_e32 %0, 0, %1" : "=v"(r) : "v"(x)); return r; }
typedef __bf16 bf16x2_t __attribute__((ext_vector_type(2)));
__device__ __forceinline__ unsigned cvtpk_s(float lo, float hi) { f32x2 v = {lo, hi}; bf16x2_t b = __builtin_convertvector(v, bf16x2_t); return __builtin_bit_cast(unsigned, b); }
__device__ __forceinline__ int crow(int r, int hi) { return (r & 3) + 8 * (r >> 2) + 4 * hi; }
__device__ __forceinline__ float wave_sum(float v) {
#pragma unroll
    for (int o = 1; o < 64; o <<= 1) v += __shfl_xor(v, o);
    return v;
}

namespace pg8 {
constexpr int BM = 256, BK = 64, HALF = 128, HTB = HALF * BK * 2, STAGE_BYTES = 8 * HTB, NXCD = 8, WGM = 8;
__host__ __device__ __forceinline__ int lds_byte(int r, int c) { const int st = (r >> 4) * 2 + (c >> 5), rr = r & 15, cc = c & 31, ob = rr * 64 + cc * 2; return st * 1024 + (ob ^ (((ob >> 9) & 1) << 5)); }
__host__ __device__ __forceinline__ void stage_rc(int b, int& R, int& C) { const int st = b / 1024, sb = b % 1024, swz = sb ^ (((sb >> 9) & 1) << 5); R = (st >> 1) * 16 + swz / 64; C = (st & 1) * 32 + (swz % 64) / 2; }
__host__ __device__ __forceinline__ int perm32(int rho) { const int n = rho >> 4, i = rho & 15; return 8 * (i >> 2) + 4 * n + (i & 3); }

struct Unit { int pm, pn; };
struct Gemm { const bf16_t* A; const bf16_t* Bt; int M, N, K, lda; };

struct StaticOrder {
    int nM, nN, nwg, G, c;
    __host__ __device__ void init(int M, int N, int G_, int c_) { nM = M / BM; nN = N / BM; nwg = nM * nN; G = G_; c = c_; }
    __host__ __device__ bool next(int i, Unit& u) const {
        const long L = (long)i * G + c; if (L >= nwg) return false;
        int wgid = (int)L; { const int q = nwg / NXCD, r = nwg % NXCD, xcd = wgid % NXCD, off = wgid / NXCD; wgid = (xcd < r ? xcd * (q + 1) : r * (q + 1) + (xcd - r) * q) + off; }
        const int nig = WGM * nN, gid = wgid / nig, fm = gid * WGM, gsz = (nM - fm) < WGM ? (nM - fm) : WGM;
        u.pm = fm + ((wgid % nig) % gsz); u.pn = (wgid % nig) / gsz; return true;
    }
};
struct OneUnit {
    int pm; bool on;
    __device__ bool next(int i, Unit& u) const { if (i > 0 || !on) return false; u.pm = pm; u.pn = 0; return true; }
};

template <class Epi, class Sched, bool ALIGN_EPI>
__device__ __forceinline__ void gemm_phase(LAS unsigned char* lds, const Gemm g, const Sched& S, const Epi& E) {
    const int tid = threadIdx.x, wid = __builtin_amdgcn_readfirstlane(tid >> 6), lane = tid & 63, wr = wid >> 2, wc = wid & 3, fr = lane & 15, fq = lane >> 4;
    int K_ = g.K, lda_ = g.lda; asm volatile("" : "+s"(K_), "+s"(lda_));
    const int K = K_, nt = K / BK, lda = lda_;
    unsigned voffA[2], voffB[2];
#pragma unroll
    for (int i = 0; i < 2; ++i) { int R, C; stage_rc(tid * 16 + i * 8192, R, C); const int Rb = (R & ~31) + perm32(R & 31);
        voffA[i] = (unsigned)(R * lda + C) * 2u; voffB[i] = (unsigned)(Rb * K + C) * 2u; }
    const size_t kstep = (size_t)(BK * 2);
    const size_t hstepA = (size_t)HALF * lda * 2, hstepB = (size_t)HALF * K * 2;
    const size_t tstepA = 2 * hstepA, tstepB = 2 * hstepB;
    const unsigned ldsw = (unsigned)wid * 1024u;
    const int aoff = lds_byte(wr * 64 + fr, fq * 8), boff = lds_byte(wc * 32 + fr, fq * 8);
#define PG8_SA(b, h) (((b) * 2 + (h)) * HTB)
#define PG8_SB(b, h) ((4 + (b) * 2 + (h)) * HTB)
#define PG8_STAGE(bufoff, gbase, voff) do { _Pragma("unroll") for (int _i = 0; _i < 2; ++_i) \
        __builtin_amdgcn_global_load_lds((const unsigned*)((const char*)(gbase) + (voff)[_i]), (LAS unsigned*)(lds + (bufoff) + ldsw + _i * 8192), 16, 0, 0); } while (0)
#define PG8_LDA(dst, b, h) do { _Pragma("unroll") for (int m = 0; m < 4; ++m) _Pragma("unroll") for (int k = 0; k < 2; ++k) dst[m][k] = *(const LAS bf16x8*)(lds + PG8_SA(b, h) + aoff + m * 2048 + k * 1024); } while (0)
#define PG8_LDB(dst, b, h) do { _Pragma("unroll") for (int n = 0; n < 2; ++n) _Pragma("unroll") for (int k = 0; k < 2; ++k) dst[n][k] = *(const LAS bf16x8*)(lds + PG8_SB(b, h) + boff + n * 2048 + k * 1024); } while (0)
#define PG8_MMA(ai, bj, At, Bt) do { __builtin_amdgcn_s_setprio(1); _Pragma("unroll") for (int m = 0; m < 4; ++m) _Pragma("unroll") for (int n = 0; n < 2; ++n) _Pragma("unroll") for (int k = 0; k < 2; ++k) \
        acc[ai][bj][m][n] = __builtin_amdgcn_mfma_f32_16x16x32_bf16(Bt[n][k], At[m][k], acc[ai][bj][m][n], 0, 0, 0); __builtin_amdgcn_s_setprio(0); } while (0)
#define PG8_WAIT_V(n) asm volatile("s_waitcnt vmcnt(" #n ")" ::: "memory")
#define PG8_WAIT_L(n) asm volatile("s_waitcnt lgkmcnt(" #n ")" ::: "memory")
#define PG8_BAR __builtin_amdgcn_s_barrier()
#define PG8_SCHED __builtin_amdgcn_sched_barrier(0)
    Unit cur, nxt; int ui = 0;
    if (!S.next(0, cur)) return;
    f32x4 acc[2][2][4][2];
#pragma unroll
    for (int a = 0; a < 2; ++a)
#pragma unroll
        for (int b = 0; b < 2; ++b)
#pragma unroll
            for (int m = 0; m < 4; ++m)
#pragma unroll
                for (int n = 0; n < 2; ++n) acc[a][b][m][n] = (f32x4){0.f, 0.f, 0.f, 0.f};
    bf16x8 At[4][2], B0[2][2], B1[2][2];
    const char* cA = (const char*)g.A + (size_t)cur.pm * tstepA; const char* cB = (const char*)g.Bt + (size_t)cur.pn * tstepB;
    PG8_STAGE(PG8_SB(0, 0), cB, voffB); PG8_STAGE(PG8_SB(0, 1), cB + hstepB, voffB); PG8_STAGE(PG8_SA(0, 0), cA, voffA); PG8_STAGE(PG8_SA(0, 1), cA + hstepA, voffA);
    if (wr == 1) PG8_BAR;
    PG8_WAIT_V(2); PG8_BAR;
    PG8_STAGE(PG8_SB(1, 0), cB + kstep, voffB); PG8_STAGE(PG8_SA(1, 0), cA + kstep, voffA); PG8_STAGE(PG8_SB(1, 1), cB + hstepB + kstep, voffB);
    PG8_WAIT_V(6); PG8_BAR;
    for (;;) {
        const bool has_next = S.next(ui + 1, nxt);
        const char* nA = has_next ? (const char*)g.A + (size_t)nxt.pm * tstepA : cA; const char* nB = has_next ? (const char*)g.Bt + (size_t)nxt.pn * tstepB : cB;
        for (int t = 0; t < nt; t += 2) {
            const bool last = (t == nt - 2);
            const char* a1 = cA + (size_t)(t + 1) * kstep;
            const char* a2 = last ? nA : cA + (size_t)(t + 2) * kstep; const char* b2 = last ? nB : cB + (size_t)(t + 2) * kstep;
            const char* a3 = a2 + kstep; const char* b3 = b2 + kstep;
            PG8_LDB(B0, 0, 0); PG8_LDB(B1, 0, 1); PG8_SCHED; PG8_LDA(At, 0, 0); PG8_STAGE(PG8_SA(1, 1), a1 + hstepA, voffA);
            PG8_WAIT_V(8); PG8_WAIT_L(0); PG8_BAR; PG8_MMA(0, 0, At, B0); PG8_MMA(0, 1, At, B1); PG8_BAR; PG8_SCHED;
            PG8_LDA(At, 0, 1); PG8_STAGE(PG8_SB(0, 0), b2, voffB); PG8_STAGE(PG8_SB(0, 1), b2 + hstepB, voffB); PG8_STAGE(PG8_SA(0, 0), a2, voffA);
            PG8_WAIT_V(8); PG8_WAIT_L(0); PG8_BAR; PG8_MMA(1, 0, At, B0); PG8_MMA(1, 1, At, B1); PG8_BAR; PG8_SCHED;
            PG8_LDB(B0, 1, 0); PG8_LDB(B1, 1, 1); PG8_SCHED; PG8_LDA(At, 1, 0); PG8_STAGE(PG8_SA(0, 1), a2 + hstepA, voffA);
            PG8_WAIT_V(8); PG8_WAIT_L(0); PG8_BAR; PG8_MMA(0, 0, At, B0); PG8_MMA(0, 1, At, B1); PG8_BAR; PG8_SCHED;
            PG8_LDA(At, 1, 1); PG8_STAGE(PG8_SB(1, 0), b3, voffB); PG8_STAGE(PG8_SB(1, 1), b3 + hstepB, voffB); PG8_STAGE(PG8_SA(1, 0), a3, voffA);
            PG8_WAIT_V(8); PG8_WAIT_L(0); PG8_BAR; PG8_MMA(1, 0, At, B0); PG8_MMA(1, 1, At, B1); PG8_BAR; PG8_SCHED;
        }
        if constexpr (ALIGN_EPI) { if (wr == 0) PG8_BAR; }
        E(acc, cur, wr, wc, fr, fq);
        if (!has_next) break;
#pragma unroll
        for (int a = 0; a < 2; ++a)
#pragma unroll
            for (int b = 0; b < 2; ++b)
#pragma unroll
                for (int m = 0; m < 4; ++m)
#pragma unroll
                    for (int n = 0; n < 2; ++n) acc[a][b][m][n] = (f32x4){0.f, 0.f, 0.f, 0.f};
        cur = nxt; cA = nA; cB = nB; ++ui;
        if constexpr (ALIGN_EPI) { if (wr == 1) PG8_BAR; }
    }
    PG8_WAIT_V(0);
    if constexpr (!ALIGN_EPI) { if (wr == 0) PG8_BAR; }
    PG8_BAR;
#undef PG8_SA
#undef PG8_SB
#undef PG8_STAGE
#undef PG8_LDA
#undef PG8_LDB
#undef PG8_MMA
#undef PG8_WAIT_V
#undef PG8_WAIT_L
#undef PG8_BAR
#undef PG8_SCHED
}

#define EPI_ROWS_BEGIN _Pragma("unroll") for (int ai = 0; ai < 2; ++ai) _Pragma("unroll") for (int m = 0; m < 4; ++m) { const int row = u.pm * BM + ai * HALF + wr * 64 + m * 16 + fr;
#define EPI_ROWS_END asm volatile("" ::: "memory"); }
#define EPI_V8(v, ai, bj, m) float v[8] = {acc[ai][bj][m][0][0], acc[ai][bj][m][0][1], acc[ai][bj][m][0][2], acc[ai][bj][m][0][3], acc[ai][bj][m][1][0], acc[ai][bj][m][1][1], acc[ai][bj][m][1][2], acc[ai][bj][m][1][3]}

struct EpiInProj {
    unsigned char* ws;
    __device__ __forceinline__ void operator()(const f32x4 (&acc)[2][2][4][2], const Unit& u, int wr, int wc, int fr, int fq) const {
        const float* rope = (const float*)(ws + WS_ROPE);
#pragma unroll
        for (int bj = 0; bj < 2; ++bj) {
            const int seg = 2 * u.pn + bj;
            const int cl = wc * 32 + 8 * fq;
            const bool ropeseg = !(seg == 5 || seg == 7 || seg == 9 || seg == 14);
            const bool dorope = ropeseg && ((wc & 1) == 0);
            EPI_ROWS_BEGIN
                EPI_V8(v, ai, bj, m);
                if (dorope) {
                    float p[8];
#pragma unroll
                    for (int j = 0; j < 8; ++j) p[j] = __shfl_xor(v[j], 16);
                    if (fq < 2) {
                        const float* T = rope + (size_t)(row & (SEQ - 1)) * 16;
                        const f32x4 c0 = *(const f32x4*)T, c1 = *(const f32x4*)(T + 4), s0 = *(const f32x4*)(T + 8), s1 = *(const f32x4*)(T + 12);
                        const float cc[8] = {c0[0], c0[1], c0[2], c0[3], c1[0], c1[1], c1[2], c1[3]};
                        const float ss[8] = {s0[0], s0[1], s0[2], s0[3], s1[0], s1[1], s1[2], s1[3]};
                        const float sg = (fq == 0) ? -1.f : 1.f;
#pragma unroll
                        for (int j = 0; j < 8; ++j) v[j] = v[j] * cc[j] + sg * p[j] * ss[j];
                    }
                }
                if (seg < 4 || (seg >= 10 && seg < 14)) {
#pragma unroll
                    for (int j = 0; j < 8; ++j) v[j] *= C2;
                    bf16_t* base = (bf16_t*)(ws + (seg < 4 ? WS_QN : WS_QD));
                    const int sl = seg < 4 ? seg : seg - 10;
                    *(u32x4*)(base + (size_t)row * 512 + sl * 128 + cl) = pack8(v);
                } else if (seg >= 4 && seg < 10) {
                    bf16_t* base = (bf16_t*)(ws + WS_KCR + (size_t)(seg - 4) * PLANE_BUF);
                    const int g = cl >> 6, d = cl & 63;
                    const size_t prow = (size_t)row + (size_t)((row >> 11) + g) * SEQ;
                    if (seg == 7 || seg == 9) {
                        bf16_t* tp = base + (prow >> 6) * 4096 + (size_t)d * 64 + (prow & 63);
#pragma unroll
                        for (int j = 0; j < 8; ++j) tp[j * 64] = (bf16_t)(cvt_pk_bf16(v[j], 0.f) & 0xffffu);
                    } else {
                        *(u32x4*)(base + prow * 64 + d) = pack8(v);
                    }
                } else if (seg == 14) {
                    bf16_t* base = (bf16_t*)(ws + WS_CRAW);
                    *(u32x4*)(base + (size_t)row * 256 + cl) = pack8(v);
                    *(u32x4*)(base + (size_t)row * 256 + 128 + cl) = (u32x4){0u, 0u, 0u, 0u};
                    float s = 0.f;
#pragma unroll
                    for (int j = 0; j < 8; ++j) s += v[j] * v[j];
                    s += __shfl_xor(s, 16); s += __shfl_xor(s, 32);
                    if (fq == 0) ((float*)(ws + WS_SSQC))[(size_t)row * 4 + wc] = s;
                } else if (seg >= 15 && seg < 19) {
                    bf16_t* base = (bf16_t*)(ws + WS_QI);
                    *(u32x4*)(base + (size_t)row * 512 + (seg - 15) * 128 + cl) = pack8(v);
                } else {
                    if (cl < 64) { *(u32x4*)((bf16_t*)(ws + WS_KI) + (size_t)row * 64 + cl) = pack8(v); }
                    else if (cl < 80) { *(u32x4*)((bf16_t*)(ws + WS_KR) + (size_t)row * 16 + (cl - 64)) = pack8(v); }
                    else if (cl < 104) {
                        float* gp = (float*)(ws + WS_GT) + (size_t)row * 24 + (cl - 80);
                        f32x4 a, b;
                        a[0] = fast_rcp(1.f + __expf(-v[0])); a[1] = fast_rcp(1.f + __expf(-v[1])); a[2] = fast_rcp(1.f + __expf(-v[2])); a[3] = fast_rcp(1.f + __expf(-v[3]));
                        b[0] = fast_rcp(1.f + __expf(-v[4])); b[1] = fast_rcp(1.f + __expf(-v[5])); b[2] = fast_rcp(1.f + __expf(-v[6])); b[3] = fast_rcp(1.f + __expf(-v[7]));
                        *(f32x4*)gp = a; *(f32x4*)(gp + 4) = b;
                    } else if (cl < 112) {
                        const float sc = 0.35355339059327373f * 0.125f;
                        float* wp = (float*)(ws + WS_WI) + (size_t)row * 8;
                        *(f32x4*)wp = (f32x4){v[0] * sc, v[1] * sc, v[2] * sc, v[3] * sc}; *(f32x4*)(wp + 4) = (f32x4){v[4] * sc, v[5] * sc, v[6] * sc, v[7] * sc};
                    }
                }
            EPI_ROWS_END
        }
    }
};

struct EpiKvGen {
    unsigned char* ws;
    __device__ __forceinline__ void operator()(const f32x4 (&acc)[2][2][4][2], const Unit& u, int wr, int wc, int fr, int fq) const {
        const float* ssq = (const float*)(ws + WS_SSQC);
        const bf16_t* Kr = (const bf16_t*)(ws + WS_KR);
        EPI_ROWS_BEGIN
            const f32x4 q = *(const f32x4*)(ssq + (size_t)row * 4);
            const float rstd = 1.0f / sqrtf(((q[0] + q[1]) + (q[2] + q[3])) * (1.f / 128.f) + EPS);
#pragma unroll
            for (int bj = 0; bj < 2; ++bj) {
                const int col = u.pn * BM + bj * HALF + wc * 32 + 8 * fq;
                EPI_V8(v, ai, bj, m);
#pragma unroll
                for (int j = 0; j < 8; ++j) v[j] *= rstd;
                u32x4 w = pack8(v);
                if (col < 512) {
                    if ((col & 63) < 16) w = *(const u32x4*)(Kr + (size_t)row * 16 + (col & 63));
                    *(u32x4*)((bf16_t*)(ws + WS_KD) + (size_t)row * 512 + col) = w;
                } else {
                    const int hh = (col - 512) >> 6, d = col & 63, bb = row >> 11, sp = row & (SEQ - 1);
                    bf16_t* tp = (bf16_t*)(ws + WS_VD) + ((size_t)(bb * 8 + hh) * 32 + (sp >> 6)) * 4096 + (size_t)d * 64 + (sp & 63);
#pragma unroll
                    for (int j = 0; j < 8; ++j) tp[j * 64] = (bf16_t)(cvt_pk_bf16(v[j], 0.f) & 0xffffu);
                }
            }
        EPI_ROWS_END
    }
};

__device__ __forceinline__ float gelu_tanh(float x) {
    const float t = 0.7978845608028654f * (x + 0.044715f * x * x * x);
    const float e = __expf(2.f * t);
    const float th = 1.f - 2.f * fast_rcp(e + 1.f);
    return 0.5f * x * (1.f + th);
}
struct EpiHid {
    bf16_t* out; const float* bias;
    __device__ __forceinline__ void operator()(const f32x4 (&acc)[2][2][4][2], const Unit& u, int wr, int wc, int fr, int fq) const {
#pragma unroll
        for (int bj = 0; bj < 2; ++bj) {
            const int col = bj * HALF + wc * 32 + 8 * fq;
            const f32x4 b0 = *(const f32x4*)(bias + col), b1 = *(const f32x4*)(bias + col + 4);
            EPI_ROWS_BEGIN
                EPI_V8(v, ai, bj, m);
#pragma unroll
                for (int j = 0; j < 4; ++j) { v[j] = gelu_tanh(v[j] + b0[j]); v[4 + j] = gelu_tanh(v[4 + j] + b1[j]); }
                *(u32x4*)(out + (size_t)row * 256 + col) = pack8(v);
            EPI_ROWS_END
        }
    }
};
struct EpiCmp {
    unsigned char* ws; const float* b2; int kv;
    __device__ __forceinline__ void operator()(const f32x4 (&acc)[2][2][4][2], const Unit& u, int wr, int wc, int fr, int fq) const {
        const int col = wc * 32 + 8 * fq;
        if (col < 64) {
            const f32x4 b0 = *(const f32x4*)(b2 + col), b1 = *(const f32x4*)(b2 + col + 4);
            EPI_ROWS_BEGIN
                EPI_V8(v, ai, 0, m);
                const int n = row & 127;
#pragma unroll
                for (int j = 0; j < 4; ++j) { v[j] = (n == 127) ? 0.f : v[j] + b0[j]; v[4 + j] = (n == 127) ? 0.f : v[4 + j] + b1[j]; }
                if (kv == 0) { *(u32x4*)((bf16_t*)(ws + WS_KC) + (size_t)row * 64 + col) = pack8(v); }
                else { bf16_t* vt = (bf16_t*)(ws + WS_VCT) + (size_t)(row >> 7) * 64 * 128 + n;
#pragma unroll
                    for (int j = 0; j < 8; ++j) vt[(size_t)(col + j) * 128] = (bf16_t)(cvt_pk_bf16(v[j], 0.f) & 0xffffu); }
            EPI_ROWS_END
        }
    }
};
struct EpiY {
    bf16_t* out; float* ssq;
    __device__ __forceinline__ void operator()(const f32x4 (&acc)[2][2][4][2], const Unit& u, int wr, int wc, int fr, int fq) const {
#pragma unroll
        for (int bj = 0; bj < 2; ++bj) {
            const int col = u.pn * BM + bj * HALF + wc * 32 + 8 * fq;
            EPI_ROWS_BEGIN
                EPI_V8(v, ai, bj, m);
                float s = 0.f;
#pragma unroll
                for (int j = 0; j < 8; ++j) s += v[j] * v[j];
                s += __shfl_xor(s, 16); s += __shfl_xor(s, 32);
                if (fq == 0) ssq[(size_t)row * 32 + u.pn * 8 + bj * 4 + wc] = s;
                *(u32x4*)(out + (size_t)row * DM + col) = pack8(v);
            EPI_ROWS_END
        }
    }
};
struct EpiSwiglu {
    bf16_t* out;
    __device__ __forceinline__ void operator()(const f32x4 (&acc)[2][2][4][2], const Unit& u, int wr, int wc, int fr, int fq) const {
        const int col = u.pn * HALF + wc * 32 + 8 * fq;
        EPI_ROWS_BEGIN
            EPI_V8(g, ai, 0, m); EPI_V8(p, ai, 1, m);
            float v[8];
#pragma unroll
            for (int j = 0; j < 8; ++j) v[j] = g[j] * fast_rcp(1.f + __expf(-g[j])) * p[j];
            *(u32x4*)(out + (size_t)row * DFF + col) = pack8(v);
        EPI_ROWS_END
    }
};
}

#define XB_TMO      128
#define XB_XCNT(j)  (256  + 64 * (j))
#define XB_XSUB(j)  (1280 + 64 * (j))
#define XB_XGEN(j)  (2304 + 64 * (j))
#define XB_TOP      3328
#define XB_TOPGEN   3392
#define XCD_BAR_WORDS 3456
#define XB_SPIN_CAP (1u << 18)
__device__ __forceinline__ unsigned xb_ld(unsigned* p)              { return __hip_atomic_load(p, __ATOMIC_RELAXED, __HIP_MEMORY_SCOPE_AGENT); }
__device__ __forceinline__ unsigned xb_add(unsigned* p, unsigned v) { return __hip_atomic_fetch_add(p, v, __ATOMIC_RELAXED, __HIP_MEMORY_SCOPE_AGENT); }
__device__ __forceinline__ unsigned xb_xcc_id() { return (unsigned)__builtin_amdgcn_s_getreg((3 << 11) | 20) & 0xFu; }
#define XB_SPIN(cond, bar) do { unsigned _sp = 0; while (cond) { __builtin_amdgcn_s_sleep(1); \
    if ((++_sp & 255u) == 0u) { if (xb_ld(&(bar)[XB_TMO])) break; if (_sp > XB_SPIN_CAP) { atomicAdd(&(bar)[XB_TMO], 1u); break; } } } } while (0)
struct XcdBarrier { unsigned* bar; unsigned x; volatile LAS unsigned* st; };
__device__ __forceinline__ XcdBarrier xcd_barrier_post(unsigned* bar, volatile LAS unsigned* st) {
    XcdBarrier b; b.bar = bar; b.x = xb_xcc_id(); b.st = st;
    if (threadIdx.x == 0) (void)xb_add(&bar[XB_XCNT(b.x)], 1u);
    return b;
}
__device__ __forceinline__ void xcd_barrier_complete(unsigned* bar, unsigned x, unsigned& nloc, unsigned& nx) {
    const unsigned G = gridDim.x * gridDim.y * gridDim.z;
    unsigned sum, cnt, mine, sp = 0u;
    for (;;) {
        sum = 0u; cnt = 0u; mine = 0u;
#pragma unroll
        for (unsigned j = 0; j < 16; ++j) { const unsigned c = xb_ld(&bar[XB_XCNT(j)]); sum += c; cnt += (c > 0u) ? 1u : 0u; mine = (j == x) ? c : mine; }
        if (sum == G) break;
        __builtin_amdgcn_s_sleep(1);
        if ((++sp & 255u) == 0u) { if (xb_ld(&bar[XB_TMO])) break; if (sp > XB_SPIN_CAP) { atomicAdd(&bar[XB_TMO], 1u); break; } }
    }
    nloc = mine > 0u ? mine : 1u; nx = cnt > 0u ? cnt : 1u;
}
__device__ __forceinline__ void xcd_barrier(const XcdBarrier& b) {
    asm volatile("s_waitcnt vmcnt(0)" ::: "memory");
    __syncthreads();
    if (threadIdx.x == 0) {
        unsigned* bar = b.bar;
        __builtin_amdgcn_s_waitcnt(0);
        unsigned nloc = b.st[0], nx = b.st[1];
        if (nloc == 0u) { xcd_barrier_complete(bar, b.x, nloc, nx); b.st[0] = nloc; b.st[1] = nx; }
        const unsigned old = xb_add(&bar[XB_XSUB(b.x)], 1u);
        const unsigned gen = old / nloc;
        if (old + 1u == (gen + 1u) * nloc) {
            __builtin_amdgcn_fence(__ATOMIC_RELEASE, "agent");
            asm volatile("s_waitcnt vmcnt(0)" ::: "memory");
            const unsigned og = xb_add(&bar[XB_TOP], 1u);
            const unsigned tg = og / nx;
            if (og + 1u == (tg + 1u) * nx) xb_add(&bar[XB_TOPGEN], 1u);
            else XB_SPIN(xb_ld(&bar[XB_TOPGEN]) == tg, bar);
            __builtin_amdgcn_fence(__ATOMIC_ACQUIRE, "agent");
            xb_add(&bar[XB_XGEN(b.x)], 1u);
            asm volatile("s_waitcnt vmcnt(0)" ::: "memory");
        } else {
            XB_SPIN(xb_ld(&bar[XB_XGEN(b.x)]) == gen, bar);
            __builtin_amdgcn_fence(__ATOMIC_ACQUIRE, "agent");
            asm volatile("s_waitcnt vmcnt(0)" ::: "memory");
        }
    }
    __syncthreads();
}

struct Args { const float* in[20]; float* out; unsigned char* ws; int ph_lo, ph_hi, li, pad; };
enum { I_X = 0, I_C, I_WADA, I_BADA, I_GPM, I_GQM, I_GPF, I_GQF, I_WIN, I_PE, I_CW1, I_CB1, I_CW2, I_CB2, I_GKV, I_WUK, I_WUV, I_WOUT, I_WGU, I_WDN };

struct ColSrc { const float* p; int ld; int kmax; };
__device__ __forceinline__ ColSrc col_src(const Args& a, int mat, int n) {
    ColSrc c; c.p = nullptr; c.ld = 0; c.kmax = 1 << 30;
    switch (mat) {
    case 0: { int sc;
        if (n < 1280) sc = n; else if (n < 1920) sc = n + 24; else if (n < 2496) sc = n + 40; else if (n < 2512) sc = n - 552; else if (n < 2536) sc = n - 1232; else if (n < 2544) sc = n; else sc = -1;
        if (sc >= 0) c.p = a.in[I_WIN] + sc; c.ld = 2544; break; }
    case 1: c.p = a.in[I_WOUT] + n; c.ld = DM; break;
    case 2: { const int pn = n >> 8, jj = n & 255, bj = jj >> 7, col = pn * 128 + (jj & 127); c.p = a.in[I_WGU] + bj * DFF + col; c.ld = NGU; break; }
    case 3: c.p = a.in[I_WDN] + n; c.ld = DM; break;
    case 4: { c.kmax = 128;
        if (n < 512) { const int h = n >> 6, d = n & 63; if (d >= 16) c.p = a.in[I_WUK] + (size_t)h * 128 * 48 + (d - 16); c.ld = 48; }
        else { const int h = (n - 512) >> 6, d = n & 63; c.p = a.in[I_WUV] + (size_t)h * 128 * 64 + d; c.ld = 64; }
        break; }
    case 5: case 6: { if (n < 128) c.p = a.in[I_CW1] + (size_t)(mat - 5) * 2048 * 128 + n; c.ld = 128; break; }
    default: { c.kmax = 128; if (n < 64) c.p = a.in[I_CW2] + (size_t)(mat - 7) * 128 * 64 + n; c.ld = 64; break; }
    }
    return c;
}
__device__ __forceinline__ void p0_transpose_item(const Args& a, int mat, int K, bf16_t* WT, int kb, int nb, LAS float* scr, int lane) {
    const int k0 = 64 * kb, n0 = 32 * nb;
    const ColSrc c = col_src(a, mat, n0 + (lane & 31));
    const bool live = (c.p != nullptr) && (k0 < c.kmax);
    const float* p = live ? c.p + (size_t)(k0 + (lane >> 5)) * c.ld : a.in[I_GKV];
    const size_t step = live ? (size_t)2 * c.ld : 0;
    float v[32];
#pragma unroll
    for (int i = 0; i < 32; ++i) v[i] = p[(size_t)i * step];
    if (mat == 4) {
#pragma unroll
        for (int i = 0; i < 32; ++i) v[i] *= a.in[I_GKV][(k0 + 2 * i + (lane >> 5)) & 127];
    }
#pragma unroll
    for (int i = 0; i < 32; ++i) scr[(2 * i + (lane >> 5)) * 33 + (lane & 31)] = live ? v[i] : 0.f;
    asm volatile("s_waitcnt lgkmcnt(0)" ::: "memory");
    const int cc = lane & 7;
#pragma unroll
    for (int j = 0; j < 4; ++j) { const int n = (lane >> 3) + 8 * j; const LAS float* sp = scr + (8 * cc) * 33 + n;
        u32x4 o; o.x = cvt_pk_bf16(sp[0 * 33], sp[1 * 33]); o.y = cvt_pk_bf16(sp[2 * 33], sp[3 * 33]); o.z = cvt_pk_bf16(sp[4 * 33], sp[5 * 33]); o.w = cvt_pk_bf16(sp[6 * 33], sp[7 * 33]);
        *(u32x4*)(WT + (size_t)(n0 + n) * K + k0 + 8 * cc) = o; }
    asm volatile("s_waitcnt lgkmcnt(0)" ::: "memory");
}
__device__ __forceinline__ void p0_prologue(const Args& a, LAS unsigned char* lds) {
    unsigned char* ws = a.ws;
    const int tid = threadIdx.x, lane = tid & 63, wave = tid >> 6, G = gridDim.x, blk = blockIdx.x;
    __syncthreads();
    {
        LAS float* cact = (LAS float*)lds;
        LAS float* red = (LAS float*)(lds + 65536);
        for (int i = tid; i < NB * DM; i += 512) { const float c = a.in[I_C][i]; cact[i] = c * fast_rcp(1.f + __expf(-c)); }
        __syncthreads();
        for (int cb = blk; cb < 256; cb += G) {
            const int ks = tid >> 5, jj = tid & 31, col = cb * 24 + jj;
            float accv[16];
#pragma unroll
            for (int b = 0; b < 16; ++b) accv[b] = 0.f;
            if (jj < 24) {
#pragma unroll 1
                for (int k0 = ks * 64; k0 < ks * 64 + 64; k0 += 16) {
                    float wv[16];
#pragma unroll
                    for (int kk = 0; kk < 16; ++kk) wv[kk] = a.in[I_WADA][(size_t)(k0 + kk) * 6144 + col];
#pragma unroll
                    for (int kk = 0; kk < 16; ++kk)
#pragma unroll
                        for (int b = 0; b < 16; ++b) accv[b] += cact[b * DM + k0 + kk] * wv[kk];
                }
#pragma unroll
                for (int b = 0; b < 16; ++b) red[(ks * 16 + b) * 24 + jj] = accv[b];
            }
            __syncthreads();
            if (tid < 384) { const int b = tid / 24, j2 = tid % 24; float s = 0.f;
#pragma unroll
                for (int k2 = 0; k2 < 16; ++k2) s += red[(k2 * 16 + b) * 24 + j2];
                ((float*)(ws + WS_MOD))[(size_t)b * 6144 + cb * 24 + j2] = s + a.in[I_BADA][cb * 24 + j2]; }
            __syncthreads();
        }
    }
    if (blk < 32) {
        LAS float* red = (LAS float*)lds;
        const int kv = blk >> 4, ks = blk & 15, j = tid & 127, q = tid >> 7; float s = 0.f;
        const float* pe = a.in[I_PE] + (size_t)kv * 2048 + ks * 128 + q * 32;
        const float* w1 = a.in[I_CW1] + ((size_t)kv * 2048 + ks * 128 + q * 32) * 128 + j;
        float wv[32];
#pragma unroll
        for (int k = 0; k < 32; ++k) wv[k] = w1[(size_t)k * 128];
#pragma unroll
        for (int k = 0; k < 32; ++k) s += pe[k] * wv[k];
        red[tid] = s; __syncthreads();
        if (tid < 128) ((float*)(ws + WS_B1PP))[(kv * 16 + ks) * 128 + tid] = (red[tid] + red[tid + 128]) + (red[tid + 256] + red[tid + 384]);
        __syncthreads();
    }
    for (int e = blk * 512 + tid; e < SEQ * 8; e += G * 512) {
        const int pos = e >> 3, i = e & 7;
        const float inv = (float)exp(-(double)i * 0.125 * 13.122363377404328);
        const float ang = (float)pos * inv;
        double x = (double)ang; const double n = rint(x * 0.15915494309189535); x = x - n * 6.283185307179586;
        const double x2 = x * x;
        double s = 0.0, c = 0.0, ts = x, tc = 1.0;
#pragma unroll
        for (int q = 0; q < 14; ++q) { s += ts; c += tc; ts = -ts * x2 / (double)((2 * q + 2) * (2 * q + 3)); tc = -tc * x2 / (double)((2 * q + 1) * (2 * q + 2)); }
        ((float*)(ws + WS_ROPE))[pos * 16 + i] = (float)c; ((float*)(ws + WS_ROPE))[pos * 16 + 8 + i] = (float)s;
    }
    {
        LAS float* scr = (LAS float*)(lds + wave * 16384);
        const int gw = blk * 8 + wave, NGW = G * 8;
        constexpr int I0 = 16 * 80, I1 = 16 * 32, I2 = 16 * 176, I3 = 44 * 32, I4 = 4 * 32, I5 = 32 * 8, I7 = 4 * 8;
        constexpr int NIT = I0 + I1 + I2 + I3 + I4 + 2 * I5 + 2 * I7;
        for (int it = gw; it < NIT; it += NGW) {
            int r = it;
            if (r < I0) { p0_transpose_item(a, 0, 1024, (bf16_t*)(ws + WS_WIN), r / 80, r % 80, scr, lane); continue; } r -= I0;
            if (r < I1) { p0_transpose_item(a, 1, 1024, (bf16_t*)(ws + WS_WOUT), r / 32, r % 32, scr, lane); continue; } r -= I1;
            if (r < I2) { p0_transpose_item(a, 2, 1024, (bf16_t*)(ws + WS_WGU), r / 176, r % 176, scr, lane); continue; } r -= I2;
            if (r < I3) { p0_transpose_item(a, 3, 2816, (bf16_t*)(ws + WS_WDN), r / 32, r % 32, scr, lane); continue; } r -= I3;
            if (r < I4) { p0_transpose_item(a, 4, 256, (bf16_t*)(ws + WS_WKV), r / 32, r % 32, scr, lane); continue; } r -= I4;
            if (r < I5) { p0_transpose_item(a, 5, 2048, (bf16_t*)(ws + WS_WC1), r / 8, r % 8, scr, lane); continue; } r -= I5;
            if (r < I5) { p0_transpose_item(a, 6, 2048, (bf16_t*)(ws + WS_WC1) + 256 * 2048, r / 8, r % 8, scr, lane); continue; } r -= I5;
            if (r < I7) { p0_transpose_item(a, 7, 256, (bf16_t*)(ws + WS_WC2), r / 8, r % 8, scr, lane); continue; } r -= I7;
            p0_transpose_item(a, 8, 256, (bf16_t*)(ws + WS_WC2) + 256 * 256, r / 8, r % 8, scr, lane);
        }
    }
}

__device__ __forceinline__ void p1_hnorm(const Args& a) {
    unsigned char* ws = a.ws; const float* mod = (const float*)(ws + WS_MOD);
    if (blockIdx.x == 0 && threadIdx.x < 256) {
        const int kv = threadIdx.x >> 7, j = threadIdx.x & 127; float s = a.in[I_CB1][kv * 128 + j];
        for (int ks = 0; ks < 16; ++ks) s += ((const float*)(ws + WS_B1PP))[(kv * 16 + ks) * 128 + j];
        ((float*)(ws + WS_B1P))[kv * 256 + j] = s; ((float*)(ws + WS_B1P))[kv * 256 + 128 + j] = 0.f;
    }
    const int lane = threadIdx.x & 63, gw = blockIdx.x * 8 + (threadIdx.x >> 6), NGW = gridDim.x * 8;
    f32x4 v[2][4], vn[2][4];
#pragma unroll
    for (int u = 0; u < 2; ++u) { const int row = min(gw + u * NGW, MTOK - 1); const f32x4* xr = (const f32x4*)(a.in[I_X] + (size_t)row * DM) + lane;
#pragma unroll
        for (int j = 0; j < 4; ++j) v[u][j] = __builtin_nontemporal_load(xr + 64 * j); }
#pragma unroll 1
    for (int row0 = gw; row0 < MTOK; row0 += 2 * NGW) {
#pragma unroll
        for (int u = 0; u < 2; ++u) { const int row = min(row0 + (2 + u) * NGW, MTOK - 1); const f32x4* xr = (const f32x4*)(a.in[I_X] + (size_t)row * DM) + lane;
#pragma unroll
            for (int j = 0; j < 4; ++j) vn[u][j] = __builtin_nontemporal_load(xr + 64 * j); }
#pragma unroll
        for (int u = 0; u < 2; ++u) {
            const int row = row0 + u * NGW;
            if (row < MTOK) {
                const int b = row >> 11; float s = 0.f;
#pragma unroll
                for (int j = 0; j < 4; ++j) s += (v[u][j][0] * v[u][j][0] + v[u][j][1] * v[u][j][1]) + (v[u][j][2] * v[u][j][2] + v[u][j][3] * v[u][j][3]);
                const float rstd = 1.0f / sqrtf(wave_sum(s) * (1.f / DM) + EPS);
                u32x2* o = (u32x2*)((bf16_t*)(ws + WS_H) + (size_t)row * DM) + lane;
#pragma unroll
                for (int j = 0; j < 4; ++j) { const int c = 256 * j + 4 * lane;
                    const f32x4 g = *(const f32x4*)(a.in[I_GPM] + c), sh = *(const f32x4*)(mod + (size_t)b * 6144 + c), sc = *(const f32x4*)(mod + (size_t)b * 6144 + 1024 + c);
                    float h[4];
#pragma unroll
                    for (int e = 0; e < 4; ++e) h[e] = (v[u][j][e] * rstd * g[e]) * (1.f + sc[e]) + sh[e];
                    o[64 * j] = (u32x2){cvt_pk_bf16(h[0], h[1]), cvt_pk_bf16(h[2], h[3])}; }
            }
        }
#pragma unroll
        for (int u = 0; u < 2; ++u)
#pragma unroll
            for (int j = 0; j < 4; ++j) v[u][j] = vn[u][j];
    }
}

constexpr int SC_STRIDE = 2052;
__device__ __forceinline__ unsigned fkey(float f) { unsigned u = __float_as_uint(f); if (u == 0x80000000u) u = 0u; return (u >> 31) ? ~u : (u | 0x80000000u); }
__device__ __forceinline__ int count_ge8(unsigned k0, unsigned k1, unsigned k2, unsigned k3, unsigned k4, unsigned k5, unsigned k6, unsigned k7, unsigned c) {
    u64 m0, m1, m2, m3, m4, m5, m6, m7;
    asm("v_cmp_ge_u32_e64 %0, %8, %16\n\tv_cmp_ge_u32_e64 %1, %9, %16\n\tv_cmp_ge_u32_e64 %2, %10, %16\n\tv_cmp_ge_u32_e64 %3, %11, %16\n\t"
        "v_cmp_ge_u32_e64 %4, %12, %16\n\tv_cmp_ge_u32_e64 %5, %13, %16\n\tv_cmp_ge_u32_e64 %6, %14, %16\n\tv_cmp_ge_u32_e64 %7, %15, %16"
        : "=&s"(m0), "=&s"(m1), "=&s"(m2), "=&s"(m3), "=&s"(m4), "=&s"(m5), "=&s"(m6), "=&s"(m7)
        : "v"(k0), "v"(k1), "v"(k2), "v"(k3), "v"(k4), "v"(k5), "v"(k6), "v"(k7), "v"(c));
    return (__popcll(m0) + __popcll(m1)) + (__popcll(m2) + __popcll(m3)) + ((__popcll(m4) + __popcll(m5)) + (__popcll(m6) + __popcll(m7)));
}
__device__ __forceinline__ void idx_unit(const Args& a, LAS unsigned char* lds, int b, int tile) {
    unsigned char* ws = a.ws;
    const int tid = threadIdx.x, lane = tid & 63, wid = __builtin_amdgcn_readfirstlane(tid >> 6), t0 = tile * 16;
    LAS float* SC = (LAS float*)lds;
#ifndef MK_IDX_REP_SCORE
#define MK_IDX_REP_SCORE 1
#endif
#ifndef MK_IDX_REP_SEL
#define MK_IDX_REP_SEL 1
#endif
    const bool need_scores = (t0 + 15) >= 256;
#pragma unroll 1
    for (int rs_ = 0; rs_ < MK_IDX_REP_SCORE; ++rs_)
    if (need_scores) {
        const int tq = lane & 15, fq = lane >> 4;
        const size_t trow = (size_t)b * SEQ + t0 + tq;
        const bf16_t* Qi = (const bf16_t*)(ws + WS_QI) + trow * 512;
        bf16x8 qb[8][2]; float wv[8];
#pragma unroll
        for (int h = 0; h < 8; ++h) { qb[h][0] = *(const bf16x8*)(Qi + h * 64 + 8 * fq); qb[h][1] = *(const bf16x8*)(Qi + h * 64 + 32 + 8 * fq); }
        { const f32x4 w0 = *(const f32x4*)((const float*)(ws + WS_WI) + trow * 8), w1 = *(const f32x4*)((const float*)(ws + WS_WI) + trow * 8 + 4);
          wv[0] = w0[0]; wv[1] = w0[1]; wv[2] = w0[2]; wv[3] = w0[3]; wv[4] = w1[0]; wv[5] = w1[1]; wv[6] = w1[2]; wv[7] = w1[3]; }
        const bf16_t* Ki = (const bf16_t*)(ws + WS_KI) + (size_t)b * SEQ * 64 + (size_t)tq * 64 + 8 * fq;
        bf16x8 kf[4][2];
#pragma unroll
        for (int u = 0; u < 4; ++u) { const int cs = min(wid + 8 * u, tile); kf[u][0] = *(const bf16x8*)(Ki + (size_t)cs * 1024); kf[u][1] = *(const bf16x8*)(Ki + (size_t)cs * 1024 + 32); }
#pragma unroll 1
        for (int st = wid; st <= tile; st += 32) {
#pragma unroll
            for (int u = 0; u < 4; ++u) {
                const int cs = st + 8 * u;
                const bf16x8 k0 = kf[u][0], k1 = kf[u][1];
                f32x4 sc = {0.f, 0.f, 0.f, 0.f};
                if (cs <= tile) {
                    f32x4 d[8];
#pragma unroll
                    for (int h = 0; h < 8; ++h) {
                        d[h] = __builtin_amdgcn_mfma_f32_16x16x32_bf16(k0, qb[h][0], (f32x4){0.f, 0.f, 0.f, 0.f}, 0, 0, 0);
                        d[h] = __builtin_amdgcn_mfma_f32_16x16x32_bf16(k1, qb[h][1], d[h], 0, 0, 0);
                    }
                    asm volatile("s_nop 15\n\ts_nop 7" : "+v"(d[0]), "+v"(d[1]), "+v"(d[2]), "+v"(d[3]), "+v"(d[4]), "+v"(d[5]), "+v"(d[6]), "+v"(d[7]));
#pragma unroll
                    for (int h = 0; h < 8; ++h)
#pragma unroll
                        for (int j = 0; j < 4; ++j) sc[j] += wv[h] * relu1(d[h][j]);
                }
                { const int cn = min(cs + 32, tile); kf[u][0] = *(const bf16x8*)(Ki + (size_t)cn * 1024); kf[u][1] = *(const bf16x8*)(Ki + (size_t)cn * 1024 + 32); }
                if (cs <= tile) *(LAS u32x4*)(SC + tq * SC_STRIDE + cs * 16 + 4 * fq) = (u32x4){fkey(sc[0]), fkey(sc[1]), fkey(sc[2]), fkey(sc[3])};
            }
        }
    }
    __syncthreads();
#pragma unroll 1
    for (int rsel_ = 0; rsel_ < MK_IDX_REP_SEL; ++rsel_) {
    const LAS unsigned* KEY = (const LAS unsigned*)lds;
    const int ta = t0 + 2 * wid, tb = ta + 1;
    u64* moa = (u64*)(ws + WS_MASKD) + ((size_t)b * SEQ + ta) * 32;
    unsigned wlo_a = 0u, whi_a = 0u, wlo_b = 0u, whi_b = 0u;
#define IDX_PUT(WLO, WHI, i, w) do { const unsigned lo_ = (unsigned)(w), hi_ = (unsigned)((w) >> 32); \
        asm volatile("s_nop 1\n\tv_writelane_b32 %0, %2, %4\n\tv_writelane_b32 %1, %3, %4" : "+v"(WLO), "+v"(WHI) : "s"(lo_), "s"(hi_), "i"(i)); } while (0)
    if (tb < 256) {
#pragma unroll
        for (int i = 0; i < 32; ++i) { const u64 wa = __ballot(64 * i + lane <= ta), wb = __ballot(64 * i + lane <= tb); IDX_PUT(wlo_a, whi_a, i, wa); IDX_PUT(wlo_b, whi_b, i, wb); }
    } else {
        unsigned ka[32], kb[32];
        const int nreg = (tb >> 6) + 1;
#pragma unroll
        for (int i = 0; i < 32; ++i) { const int sidx = 64 * i + lane;
            if (i < nreg) { const unsigned va = KEY[(2 * wid) * SC_STRIDE + sidx], vb = KEY[(2 * wid + 1) * SC_STRIDE + sidx]; ka[i] = (sidx <= ta) ? va : 0u; kb[i] = (sidx <= tb) ? vb : 0u; }
            else { ka[i] = 0u; kb[i] = 0u; } }
        unsigned Ta = 0u, Tb = 0u; bool ea = false, eb = false;
#pragma unroll 1
        for (int bit = 31; bit >= 0; --bit) {
            if (!ea) {
                const unsigned c = Ta | (1u << bit); int cnt = 0;
#pragma unroll
                for (int i0 = 0; i0 < 32; i0 += 8) if (i0 < nreg) cnt += count_ge8(ka[i0], ka[i0 + 1], ka[i0 + 2], ka[i0 + 3], ka[i0 + 4], ka[i0 + 5], ka[i0 + 6], ka[i0 + 7], c);
                if (cnt >= 256) { Ta = c; ea = (cnt == 256); }
            }
            if (!eb) {
                const unsigned c = Tb | (1u << bit); int cnt = 0;
#pragma unroll
                for (int i0 = 0; i0 < 32; i0 += 8) if (i0 < nreg) cnt += count_ge8(kb[i0], kb[i0 + 1], kb[i0 + 2], kb[i0 + 3], kb[i0 + 4], kb[i0 + 5], kb[i0 + 6], kb[i0 + 7], c);
                if (cnt >= 256) { Tb = c; eb = (cnt == 256); }
            }
            if (ea && eb) break;
        }
#define IDX_FINISH(K, T, EX, WLO, WHI) do { \
            if (EX) { _Pragma("unroll") for (int i = 0; i < 32; ++i) { const u64 w_ = __ballot(K[i] >= T); IDX_PUT(WLO, WHI, i, w_); } } \
            else { int ngt_ = 0; _Pragma("unroll") for (int i = 0; i < 32; ++i) ngt_ += __popcll(__ballot(K[i] > T)); \
                int need_ = 256 - ngt_;                            \
                _Pragma("unroll") for (int i = 0; i < 32; ++i) { const bool gt_ = K[i] > T, eq_ = K[i] == T; const u64 em_ = __ballot(eq_); \
                    const int before_ = __popcll(em_ & ((1ull << lane) - 1ull)); const bool take_ = eq_ && (before_ < need_); const u64 w_ = __ballot(gt_ || take_); \
                    need_ -= __popcll(em_); if (need_ < 0) need_ = 0; IDX_PUT(WLO, WHI, i, w_); } } } while (0)
        IDX_FINISH(ka, Ta, ea, wlo_a, whi_a);
        IDX_FINISH(kb, Tb, eb, wlo_b, whi_b);
#undef IDX_FINISH
    }
#undef IDX_PUT
    if (lane < 32) { moa[lane] = ((u64)whi_a << 32) | wlo_a; moa[32 + lane] = ((u64)whi_b << 32) | wlo_b; }
    }
    __syncthreads();
}

constexpr int PS_STRIDE = 132;
constexpr int CMP_KC_OFF = 36864, CMP_KC_STR = 144, CMP_VT_OFF = CMP_KC_OFF + 128 * CMP_KC_STR, CMP_VT_STR = 264;
__device__ __forceinline__ void cmp_unit(const Args& a, LAS unsigned char* lds, int plane, int tt) {
    unsigned char* ws = a.ws;
    const int tid = threadIdx.x, lane = tid & 63, wid = __builtin_amdgcn_readfirstlane(tid >> 6), r32 = lane & 31, hi = lane >> 5;
    const int b = plane >> 1, g = plane & 1, t0 = tt * 64;
    const int tl = r32 >> 2, hd = r32 & 3, t = t0 + 8 * wid + tl;
    const size_t trow = (size_t)b * SEQ + t;
    const int nmax = (t0 + 32) >> 4, nbmax = nmax >> 5;
    const bf16_t* Qn = (const bf16_t*)(ws + WS_QN) + trow * 512 + (g * 4 + hd) * 64;
    bf16x8 qr[4];
#pragma unroll
    for (int d0 = 0; d0 < 4; ++d0) qr[d0] = *(const bf16x8*)(Qn + d0 * 16 + hi * 8);
    const LAS unsigned char* KC = lds + CMP_KC_OFF;
    f32x16 p[4];
    {
        bf16x8 kf[4][4];
#pragma unroll
        for (int nb = 0; nb < 4; ++nb)
#pragma unroll
            for (int d0 = 0; d0 < 4; ++d0) kf[nb][d0] = *(const LAS bf16x8*)(KC + (nb * 32 + r32) * CMP_KC_STR + (d0 * 16 + hi * 8) * 2);
#pragma unroll
        for (int nb = 0; nb < 4; ++nb) {
            p[nb] = (f32x16){0.f, 0.f, 0.f, 0.f, 0.f, 0.f, 0.f, 0.f, 0.f, 0.f, 0.f, 0.f, 0.f, 0.f, 0.f, 0.f};
            if (nb <= nbmax) {
#pragma unroll
                for (int d0 = 0; d0 < 4; ++d0) p[nb] = __builtin_amdgcn_mfma_f32_32x32x16_bf16(kf[nb][d0], qr[d0], p[nb], 0, 0, 0);
            }
        }
    }
    const LAS unsigned char* VT = lds + CMP_VT_OFF;
    u32x2 vlo[4][2][2], vhh[4][2][2];
#pragma unroll
    for (int nb = 0; nb < 4; ++nb)
#pragma unroll
        for (int ks = 0; ks < 2; ++ks)
#pragma unroll
            for (int d0 = 0; d0 < 2; ++d0) { const LAS unsigned char* vp = VT + (d0 * 32 + r32) * CMP_VT_STR + (nb * 32 + ks * 16 + 4 * hi) * 2; vlo[nb][ks][d0] = *(const LAS u32x2*)vp; vhh[nb][ks][d0] = *(const LAS u32x2*)(vp + 16); }
    const float* Gt = (const float*)(ws + WS_GT);
    float rm = NEGBIG;
#pragma unroll
    for (int nb = 0; nb < 4; ++nb)
#pragma unroll
        for (int r = 0; r < 16; ++r) { const int n = nb * 32 + crow(r, hi); const bool valid = (16 * n + 31) <= t; const float sv = valid ? p[nb][r] : NEGBIG; p[nb][r] = sv; rm = fmaxf(rm, sv); }
    rm = swap_max(rm);
    if (rm < -1e29f) rm = 1e30f;
    float ls = 0.f;
#pragma unroll
    for (int nb = 0; nb < 4; ++nb)
#pragma unroll
        for (int r = 0; r < 16; ++r) { const float e = fast_exp2(p[nb][r] - rm); p[nb][r] = e; ls += e; }
    ls = swap_sum(ls);
    const float inv = 1.0f / fmaxf(ls, 1e-30f);
    LAS float* PS = (LAS float*)lds + wid * 8 * PS_STRIDE;
#pragma unroll
    for (int nb = 0; nb < 4; ++nb)
#pragma unroll
        for (int rg = 0; rg < 4; ++rg) {
            f32x4 sm;
#pragma unroll
            for (int e = 0; e < 4; ++e) { const float pn = p[nb][4 * rg + e] * inv; p[nb][4 * rg + e] = pn;
                float x = pn + quad_xor1(pn); x += quad_xor2(x); sm[e] = x; }
            *(LAS f32x4*)(PS + tl * PS_STRIDE + nb * 32 + 8 * rg + 4 * hi) = sm;
        }
    asm volatile("s_waitcnt lgkmcnt(0)" ::: "memory");
    f32x16 o[2];
    o[0] = (f32x16){0.f, 0.f, 0.f, 0.f, 0.f, 0.f, 0.f, 0.f, 0.f, 0.f, 0.f, 0.f, 0.f, 0.f, 0.f, 0.f}; o[1] = o[0];
#pragma unroll
    for (int nb = 0; nb < 4; ++nb) {
        if (nb <= nbmax) {
#pragma unroll
            for (int ks = 0; ks < 2; ++ks) {
                u32x4 pw; pw.x = cvt_pk_bf16(p[nb][8 * ks + 0], p[nb][8 * ks + 1]); pw.y = cvt_pk_bf16(p[nb][8 * ks + 2], p[nb][8 * ks + 3]);
                pw.z = cvt_pk_bf16(p[nb][8 * ks + 4], p[nb][8 * ks + 5]); pw.w = cvt_pk_bf16(p[nb][8 * ks + 6], p[nb][8 * ks + 7]);
                asm volatile("s_nop 1" : "+v"(pw));
                const bf16x8 pa = __builtin_bit_cast(bf16x8, pw);
#pragma unroll
                for (int d0 = 0; d0 < 2; ++d0) {
                    const bf16x8 vb = __builtin_bit_cast(bf16x8, (u32x4){vlo[nb][ks][d0].x, vlo[nb][ks][d0].y, vhh[nb][ks][d0].x, vhh[nb][ks][d0].y});
                    o[d0] = __builtin_amdgcn_mfma_f32_32x32x16_bf16(pa, vb, o[d0], 0, 0, 0);
                }
            }
        }
    }
    bf16_t* OC = (bf16_t*)(ws + WS_OCMP);
#pragma unroll
    for (int r = 0; r < 16; ++r) { const int q = crow(r, hi); const size_t orow = (size_t)b * SEQ + t0 + 8 * wid + (q >> 2); const int head = g * 4 + (q & 3);
        const float g0 = Gt[orow * 24 + head];
#pragma unroll
        for (int d0 = 0; d0 < 2; ++d0) OC[orow * 512 + head * 64 + d0 * 32 + r32] = (bf16_t)(cvt_pk_bf16(o[d0][r] * g0, 0.f) & 0xffffu); }
    {
        const int tk = lane & 7, blk = tt;
        float val[32];
        float prev_last = 0.f;
#pragma unroll
        for (int j = 0; j < 32; ++j) { const f32x4 x = *(const LAS f32x4*)(PS + tk * PS_STRIDE + 4 * j);
            const float imp = ((x[0] + x[1]) + (x[2] + x[3])) + prev_last; prev_last = x[3];
            val[j] = (j >= 1 && j <= blk - 2) ? imp : -INFINITY; }
        unsigned sel = 1u | (1u << blk) | (blk >= 1 ? (1u << (blk - 1)) : 0u);
#pragma unroll 1
        for (int round = 0; round < 5; ++round) {
            float best = -INFINITY; int bi = -1;
#pragma unroll
            for (int j = 0; j < 32; ++j) if (val[j] > best) { best = val[j]; bi = j; }
            if (bi >= 0) sel |= 1u << bi;
#pragma unroll
            for (int j = 0; j < 32; ++j) val[j] = (j == bi) ? -INFINITY : val[j];
        }
        if (lane < 8) ((unsigned*)(ws + WS_BM))[(size_t)plane * SEQ + t0 + 8 * wid + lane] = sel;
    }
    __syncthreads();
}

namespace fa {
constexpr int VSTR = 144, KBUF = 8192, VBUF = 64 * VSTR, OFF_V = 4 * KBUF, OFF_SCR = OFF_V + 4 * VBUF, OFF_STAGE = OFF_SCR + 2048;
__device__ __forceinline__ float bfi_f(unsigned msk, float a, float b) { return __uint_as_float((__float_as_uint(a) & msk) | (__float_as_uint(b) & ~msk)); }
template <int H>
__device__ __forceinline__ void load_k_half(const LAS unsigned char* kbuf, int r32, int hi, bf16x8 (&kf)[8]) {
    const LAS unsigned char* kb = kbuf + hi * 1024 + r32 * 16;
#pragma unroll
    for (int d0 = 2 * H; d0 < 2 * H + 2; ++d0) { kf[2 * d0] = *(const LAS bf16x8*)(kb + d0 * 2048); kf[2 * d0 + 1] = *(const LAS bf16x8*)(kb + d0 * 2048 + 512); }
}
__device__ __forceinline__ void load_k(const LAS unsigned char* kbuf, int r32, int hi, bf16x8 (&kf)[8]) {
    const LAS unsigned char* kb = kbuf + hi * 1024 + r32 * 16;
#pragma unroll
    for (int d0 = 0; d0 < 4; ++d0) { kf[2 * d0] = *(const LAS bf16x8*)(kb + d0 * 2048); kf[2 * d0 + 1] = *(const LAS bf16x8*)(kb + d0 * 2048 + 512); }
}
__device__ __forceinline__ void mma_qk(const bf16x8 (&kf)[8], const bf16x8 (&qr)[4], const f32x16& negm, f32x16& p0, f32x16& p1) {
    p0 = __builtin_amdgcn_mfma_f32_32x32x16_bf16(kf[0], qr[0], negm, 0, 0, 0); p1 = __builtin_amdgcn_mfma_f32_32x32x16_bf16(kf[1], qr[0], negm, 0, 0, 0);
#pragma unroll
    for (int d0 = 1; d0 < 4; ++d0) { p0 = __builtin_amdgcn_mfma_f32_32x32x16_bf16(kf[2 * d0], qr[d0], p0, 0, 0, 0); p1 = __builtin_amdgcn_mfma_f32_32x32x16_bf16(kf[2 * d0 + 1], qr[d0], p1, 0, 0, 0); }
}
__device__ __forceinline__ void load_v(const LAS unsigned char* vbuf, int r32, int hi, bf16x8 (&vf)[8]) {
    const LAS unsigned char* vb = vbuf + r32 * VSTR + hi * 16;
#pragma unroll
    for (int ks = 0; ks < 4; ++ks) { vf[2 * ks] = *(const LAS bf16x8*)(vb + ks * 32); vf[2 * ks + 1] = *(const LAS bf16x8*)(vb + 32 * VSTR + ks * 32); }
}
__device__ __forceinline__ void mma_pv(const bf16x8 (&vf)[8], const u32x4 (&pw)[4], f32x16& o0, f32x16& o1) {
#pragma unroll
    for (int ks = 0; ks < 4; ++ks) {
        const bf16x8 pa = __builtin_bit_cast(bf16x8, pw[ks]);
        o0 = __builtin_amdgcn_mfma_f32_32x32x16_bf16(pa, vf[2 * ks], o0, 0, 0, 0);
        o1 = __builtin_amdgcn_mfma_f32_32x32x16_bf16(pa, vf[2 * ks + 1], o1, 0, 0, 0);
    }
}
__device__ __forceinline__ void qk_mfma(const LAS unsigned char* kbuf, const bf16x8 (&qr)[4], const f32x16& negm, int r32, int hi, f32x16& p0, f32x16& p1) {
    bf16x8 kf[8]; load_k(kbuf, r32, hi, kf); mma_qk(kf, qr, negm, p0, p1);
}
__device__ __forceinline__ void pv_mfma(const LAS unsigned char* vbuf, const u32x4 (&pw)[4], int r32, int hi, f32x16& o0, f32x16& o1) {
    bf16x8 vf[8]; load_v(vbuf, r32, hi, vf); mma_pv(vf, pw, o0, o1);
}
template <int MODE>
__device__ __forceinline__ void apply_mask(int j, int j1, int t, int tw0, bool selj, u64 mbits, bool chk, int hi, f32x16& p0, f32x16& p1) {
    const int kv0 = j * 64, d = t - kv0;
    u64 w = mbits; bool need = true;
    if (MODE == 0) {
        const u64 low = (d >= 63) ? ~0ull : ((2ull << d) - 1ull);
        w = selj ? low : 0ull;
        need = (j == j1);
    } else if (MODE == 1) {
        const u64 low = (d >= 63) ? ~0ull : ((2ull << d) - 1ull);
        const int e = d - 512;
        const u64 high = (e < 0) ? ~0ull : ((e >= 63) ? 0ull : ~((2ull << e) - 1ull));
        w = low & high;
        need = !((kv0 + 63 <= tw0) && (kv0 > tw0 + 31 - 512));
    }
    if (need) {
        w >>= (4 * hi);
        const unsigned wl = (unsigned)w, wh = (unsigned)(w >> 32);
#pragma unroll
        for (int r = 0; r < 16; ++r) { const int pos = (r & 3) + 8 * (r >> 2);
            p0[r] = bfi_f((unsigned)__builtin_amdgcn_sbfe((int)wl, pos, 1), p0[r], NEGBIG);
            p1[r] = bfi_f((unsigned)__builtin_amdgcn_sbfe((int)wh, pos, 1), p1[r], NEGBIG); }
    }
}
template <bool ASM>
__device__ __forceinline__ float row_max_rel(const f32x16& p0, const f32x16& p1) {
    if (ASM) {
        float ra = max3f(p0[0], p0[1], p1[0]), rb = max3f(p0[2], p0[3], p1[1]);
        ra = max3f(ra, p1[2], p1[3]);
#pragma unroll
        for (int r = 4; r < 16; r += 4) { ra = max3f(ra, p0[r], p0[r + 1]); rb = max3f(rb, p0[r + 2], p0[r + 3]); ra = max3f(ra, p1[r], p1[r + 1]); rb = max3f(rb, p1[r + 2], p1[r + 3]); }
        float rm = max3f(ra, rb, 0.f);
        { auto rr = __builtin_amdgcn_permlane32_swap(__float_as_uint(rm), __float_as_uint(rm), false, false); rm = max3f(__uint_as_float(rr[0]), __uint_as_float(rr[1]), rm); }
        return rm;
    } else {
#define MX3(a, b, c) __builtin_fmaxf(__builtin_fmaxf((a), (b)), (c))
        float ra = MX3(p0[0], p0[1], p1[0]), rb = MX3(p0[2], p0[3], p1[1]);
        ra = MX3(ra, p1[2], p1[3]);
#pragma unroll
        for (int r = 4; r < 16; r += 4) { ra = MX3(ra, p0[r], p0[r + 1]); rb = MX3(rb, p0[r + 2], p0[r + 3]); ra = MX3(ra, p1[r], p1[r + 1]); rb = MX3(rb, p1[r + 2], p1[r + 3]); }
        float rm = MX3(ra, rb, 0.f);
        { auto rr = __builtin_amdgcn_permlane32_swap(__float_as_uint(rm), __float_as_uint(rm), false, false); rm = MX3(__uint_as_float(rr[0]), __uint_as_float(rr[1]), rm); }
#undef MX3
        return rm;
    }
}
__device__ __forceinline__ void move_reference(LAS float* scr, int r32, int hi, float rm, float& m, f32x16& negm, float& l, f32x16& o0, f32x16& o1) {
    m += rm;
#pragma unroll
    for (int r = 0; r < 16; ++r) negm[r] = -m;
    const float alpha = fast_exp2(-rm);
    l *= alpha;
    if (hi == 0) scr[r32] = alpha;
    asm volatile("s_waitcnt lgkmcnt(0)" ::: "memory");
#pragma unroll
    for (int r = 0; r < 16; ++r) { const float ar = scr[crow(r, hi)]; o0[r] *= ar; o1[r] *= ar; }
}
template <bool ASM>
__device__ __forceinline__ void range_check(LAS float* scr, int r32, int hi, f32x16& p0, f32x16& p1, float& m, f32x16& negm, float& l, f32x16& o0, f32x16& o1) {
    const float rm = row_max_rel<ASM>(p0, p1);
    if (__any(rm > 8.f)) {
#pragma unroll
        for (int r = 0; r < 16; ++r) { p0[r] -= rm; p1[r] -= rm; }
        move_reference(scr, r32, hi, rm, m, negm, l, o0, o1);
    }
}
__device__ __forceinline__ void exp_sum_pack(f32x16& p0, f32x16& p1, bool zero, u32x4 (&pw)[4], float& ls) {
    float s0 = 0.f, s1 = 0.f;
#pragma unroll
    for (int r = 0; r < 16; ++r) { p0[r] = fast_exp2(p0[r]); p1[r] = fast_exp2(p1[r]); s0 += p0[r]; s1 += p1[r]; }
    pw[0] = (u32x4){cvtpk_s(p0[0], p0[1]), cvtpk_s(p0[2], p0[3]), cvtpk_s(p0[4], p0[5]), cvtpk_s(p0[6], p0[7])};
    pw[1] = (u32x4){cvtpk_s(p0[8], p0[9]), cvtpk_s(p0[10], p0[11]), cvtpk_s(p0[12], p0[13]), cvtpk_s(p0[14], p0[15])};
    pw[2] = (u32x4){cvtpk_s(p1[0], p1[1]), cvtpk_s(p1[2], p1[3]), cvtpk_s(p1[4], p1[5]), cvtpk_s(p1[6], p1[7])};
    pw[3] = (u32x4){cvtpk_s(p1[8], p1[9]), cvtpk_s(p1[10], p1[11]), cvtpk_s(p1[12], p1[13]), cvtpk_s(p1[14], p1[15])};
    ls = s0 + s1;
    if (zero) { ls = 0.f;
#pragma unroll
        for (int q = 0; q < 4; ++q) pw[q] = (u32x4){0u, 0u, 0u, 0u}; }
}
template <int MODE>
__device__ __forceinline__ void tile_compute(LAS unsigned char* lds, int cur, int j, int j1, bool chk, const bf16x8 (&qr)[4], int t, int tw0, int tile_lim, unsigned bm, u64 mbits,
                                             LAS float* scr, int r32, int hi, float& m, f32x16& negm, float& l, f32x16& o0, f32x16& o1) {
    bool selj = true;
    if (MODE == 0) selj = (bm >> j) & 1u;
    const bool active = (MODE == 2) ? (j <= tile_lim) : true;
    if (!active) return;
    f32x16 p0, p1; u32x4 pw[4]; float ls;
    qk_mfma(lds + cur * KBUF, qr, negm, r32, hi, p0, p1);
    apply_mask<MODE>(j, j1, t, tw0, selj, mbits, chk, hi, p0, p1);
    if (chk) range_check<MODE == 2>(scr, r32, hi, p0, p1, m, negm, l, o0, o1);
    exp_sum_pack(p0, p1, (MODE == 0) && (j != j1) && !selj, pw, ls);
    l += ls;
    pv_mfma(lds + OFF_V + cur * VBUF, pw, r32, hi, o0, o1);
}
template <int MODE, class MidS, class MidL>
__device__ __forceinline__ void tile_pair(LAS unsigned char* lds, int cur, int ja, int j1, bool chk, const bf16x8 (&qr)[4], int t, int tw0, unsigned bm, u64 mbA, u64 mbB,
                                          LAS float* scr, int r32, int hi, float& m, f32x16& negm, float& l, f32x16& o0, f32x16& o1, const MidS& mid_store, const MidL& mid_load) {
    bool selA = true, selB = true;
    if (MODE == 0) { selA = (bm >> ja) & 1u; selB = (bm >> (ja + 1)) & 1u; }
    f32x16 a0, a1, b0, b1; u32x4 pwA[4], pwB[4]; float lsA, lsB;
    bf16x8 kfA[8], kfB[8], vfA[8], vfB[8];
    load_k(lds + cur * KBUF, r32, hi, kfA);
    mma_qk(kfA, qr, negm, a0, a1);
    __builtin_amdgcn_sched_group_barrier(0x100, 8, 0); __builtin_amdgcn_sched_group_barrier(0x008, 8, 0);
    load_k_half<0>(lds + (cur + 1) * KBUF, r32, hi, kfB);
    mid_store();
    apply_mask<MODE>(ja, j1, t, tw0, selA, mbA, chk, hi, a0, a1);
    float rm = 0.f;
    if (chk) rm = row_max_rel<MODE == 2>(a0, a1);
    load_k_half<1>(lds + (cur + 1) * KBUF, r32, hi, kfB);
    mma_qk(kfB, qr, negm, b0, b1);
    exp_sum_pack(a0, a1, (MODE == 0) && (ja != j1) && !selA, pwA, lsA);
#pragma unroll
    for (int g = 0; g < 4; ++g) { __builtin_amdgcn_sched_group_barrier(0x008, 1, 0); __builtin_amdgcn_sched_group_barrier(0x100, 1, 0); __builtin_amdgcn_sched_group_barrier(0x002, 12, 0); }
#pragma unroll
    for (int g = 0; g < 4; ++g) { __builtin_amdgcn_sched_group_barrier(0x008, 1, 0); __builtin_amdgcn_sched_group_barrier(0x002, 12, 0); }
    l += lsA;
    __builtin_amdgcn_sched_barrier(0);
    mid_load();
    load_v(lds + OFF_V + cur * VBUF, r32, hi, vfA);
    apply_mask<MODE>(ja + 1, j1, t, tw0, selB, mbB, false, hi, b0, b1);
    mma_pv(vfA, pwA, o0, o1);
    exp_sum_pack(b0, b1, (MODE == 0) && (ja + 1 != j1) && !selB, pwB, lsB);
#pragma unroll
    for (int g = 0; g < 8; ++g) { __builtin_amdgcn_sched_group_barrier(0x008, 1, 0); __builtin_amdgcn_sched_group_barrier(0x002, 12, 0); }
    l += lsB;
    load_v(lds + OFF_V + (cur + 1) * VBUF, r32, hi, vfB);
    mma_pv(vfB, pwB, o0, o1);
    __builtin_amdgcn_sched_group_barrier(0x100, 8, 0); __builtin_amdgcn_sched_group_barrier(0x008, 8, 0);
    if (chk && __any(rm > 8.f)) move_reference(scr, r32, hi, rm, m, negm, l, o0, o1);
}
template <int MODE, bool PRE = false>
__device__ __forceinline__ void flash_pass(LAS unsigned char* lds, const bf16_t* Kb, const bf16_t* Vt, int kvstride, int j0, int j1,
                                           const bf16x8 (&qr)[4], int t, int tw0, int tile_lim, unsigned bm, const u64* mrow, float& m, float& l, f32x16& o0, f32x16& o1) {
    f32x16 negm = (f32x16){0.f, 0.f, 0.f, 0.f, 0.f, 0.f, 0.f, 0.f, 0.f, 0.f, 0.f, 0.f, 0.f, 0.f, 0.f, 0.f};
    int tid_ = threadIdx.x; asm volatile("" : "+v"(tid_));
    const int tid = tid_, lane = tid & 63, wid = __builtin_amdgcn_readfirstlane(tid >> 6), r32 = lane & 31, hi = lane >> 5;
    const int skv = tid >> 3, sc = tid & 7;
    LAS float* scr = (LAS float*)(lds + OFF_SCR) + wid * 64;
    const bf16_t* kp = Kb + (size_t)skv * kvstride + sc * 8;
    const bf16_t* vp = Vt + tid * 8;
    const size_t kts = (size_t)64 * kvstride;
    LAS unsigned char* kdst = lds + sc * 1024 + skv * 16;
    LAS unsigned char* vdst = lds + OFF_V + skv * VSTR + (sc >> 1) * 32 + (sc & 1) * 8;
    u32x4 kA, vA, kB, vB; u64 mbA = 0ull, mbB = 0ull;
#define FA_LOAD(ja_) do { const int ja__ = min((ja_), j1), jb__ = min((ja_) + 1, j1); \
        kA = *(const u32x4*)(kp + (size_t)ja__ * kts); vA = *(const u32x4*)(vp + (size_t)ja__ * 4096); kB = *(const u32x4*)(kp + (size_t)jb__ * kts); vB = *(const u32x4*)(vp + (size_t)jb__ * 4096); } while (0)
#define FA_STORE(slot_) do { LAS unsigned char* kd_ = kdst + (slot_) * 2 * KBUF; LAS unsigned char* vd_ = vdst + (slot_) * 2 * VBUF; \
        *(LAS u32x4*)kd_ = kA; *(LAS u32x4*)(kd_ + KBUF) = kB; \
        *(LAS u32x2*)vd_ = (u32x2){vA.x, vA.y}; *(LAS u32x2*)(vd_ + 16) = (u32x2){vA.z, vA.w}; *(LAS u32x2*)(vd_ + VBUF) = (u32x2){vB.x, vB.y}; *(LAS u32x2*)(vd_ + VBUF + 16) = (u32x2){vB.z, vB.w}; } while (0)
    FA_LOAD(j0);
    if (MODE == 2) { mbA = mrow[j0]; mbB = mrow[min(j0 + 1, j1)]; }
    __syncthreads();
    FA_STORE(0);
    FA_LOAD(j0 + 2);
    __syncthreads();
    const int nt = j1 - j0 + 1;
    const int nfull = (MODE == 2) ? min((tile_lim - j0 + 1) >> 1, nt >> 1) : (nt >> 1);
    int ja = j0, slot = 0, step = 0;
#pragma unroll 1
    for (; step < nfull; ++step, ja += 2, slot ^= 1) {
        const u64 mcA = mbA, mcB = mbB;
        if (MODE == 2) { mbA = mrow[min(ja + 2, j1)]; mbB = mrow[min(ja + 3, j1)]; }
        tile_pair<MODE>(lds, 2 * slot, ja, j1, (step & 1) == 0, qr, t, tw0, bm, mcA, mcB, scr, r32, hi, m, negm, l, o0, o1,
                        [&]() { if (ja + 2 <= j1) FA_STORE(slot ^ 1); }, [&]() { FA_LOAD(ja + 4); });
        __syncthreads();
    }
#pragma unroll 1
    for (; ja <= j1; ++step, ja += 2, slot ^= 1) {
        const u64 mcA = mbA, mcB = mbB;
        if (MODE == 2) { mbA = mrow[min(ja + 2, j1)]; mbB = mrow[min(ja + 3, j1)]; }
        if (ja + 2 <= j1) FA_STORE(slot ^ 1);
        FA_LOAD(ja + 4);
        tile_compute<MODE>(lds, 2 * slot, ja, j1, (step & 1) == 0, qr, t, tw0, tile_lim, bm, mcA, scr, r32, hi, m, negm, l, o0, o1);
        if (ja + 1 <= j1) tile_compute<MODE>(lds, 2 * slot + 1, ja + 1, j1, false, qr, t, tw0, tile_lim, bm, mcB, scr, r32, hi, m, negm, l, o0, o1);
        __syncthreads();
    }
#undef FA_LOAD
#undef FA_STORE
}
__device__ __forceinline__ void row_factors(LAS unsigned char* lds, float f, float (&fr)[16]) {
    const int lane = threadIdx.x & 63, wid = __builtin_amdgcn_readfirstlane(threadIdx.x >> 6), r32 = lane & 31, hi = lane >> 5;
    LAS float* scr = (LAS float*)(lds + OFF_SCR) + wid * 64 + 32;
    if (hi == 0) scr[r32] = f;
    asm volatile("s_waitcnt lgkmcnt(0)" ::: "memory");
#pragma unroll
    for (int r = 0; r < 16; ++r) fr[r] = scr[crow(r, hi)];
    asm volatile("s_waitcnt lgkmcnt(0)" ::: "memory");
}
__device__ __forceinline__ void nsa_unit(const Args& a, LAS unsigned char* lds, int plane, int blk) {
    unsigned char* ws = a.ws;
    const int tid = threadIdx.x, lane = tid & 63, wid = __builtin_amdgcn_readfirstlane(tid >> 6), r32 = lane & 31, hi = lane >> 5;
    const int b = plane >> 1, g = plane & 1, t0 = blk * 64, hd = wid & 3, head = g * 4 + hd;
    const int tw0 = t0 + 32 * (wid >> 2), t = tw0 + r32;
    const size_t trow = (size_t)b * SEQ + t;
    const bf16_t* Qn = (const bf16_t*)(ws + WS_QN) + trow * 512 + head * 64;
    bf16x8 qr[4];
#pragma unroll
    for (int d0 = 0; d0 < 4; ++d0) qr[d0] = *(const bf16x8*)(Qn + d0 * 16 + hi * 8);
    const unsigned bm = ((const unsigned*)(ws + WS_BM))[(size_t)plane * SEQ + t];
    const float* Gt = (const float*)(ws + WS_GT) + trow * 24;
    const float g1 = Gt[8 + head], g2 = Gt[16 + head];
    const size_t pbase = (size_t)plane * SEQ * 64;
    const f32x16 z = (f32x16){0.f, 0.f, 0.f, 0.f, 0.f, 0.f, 0.f, 0.f, 0.f, 0.f, 0.f, 0.f, 0.f, 0.f, 0.f, 0.f};
    LAS float* stage = (LAS float*)(lds + OFF_STAGE) + wid * 2048 + lane;
    f32x16 res0, res1;
    {
        float m = 0.f, l = 0.f; f32x16 o0 = z, o1 = z;
        flash_pass<0>(lds, (const bf16_t*)(ws + WS_KCR + 2 * PLANE_BUF) + pbase, (const bf16_t*)(ws + WS_KCR + 3 * PLANE_BUF) + pbase, 64, 0, blk, qr, t, tw0, 0, bm, nullptr, m, l, o0, o1);
        const float f = g1 / swap_sum(l); float fr[16]; row_factors(lds, f, fr);
#pragma unroll
        for (int r = 0; r < 16; ++r) { stage[(2 * r) * 64] = o0[r] * fr[r]; stage[(2 * r + 1) * 64] = o1[r] * fr[r]; }
    }
    {
        float m = 0.f, l = 0.f; f32x16 o0 = z, o1 = z;
        const int j0 = blk >= 8 ? blk - 8 : 0;
        flash_pass<1>(lds, (const bf16_t*)(ws + WS_KCR + 4 * PLANE_BUF) + pbase, (const bf16_t*)(ws + WS_KCR + 5 * PLANE_BUF) + pbase, 64, j0, blk, qr, t, tw0, 0, 0u, nullptr, m, l, o0, o1);
        const float f = g2 / swap_sum(l); float fr[16]; row_factors(lds, f, fr);
#pragma unroll
        for (int r = 0; r < 16; ++r) { res0[r] = o0[r] * fr[r] + stage[(2 * r) * 64]; res1[r] = o1[r] * fr[r] + stage[(2 * r + 1) * 64]; }
    }
    const bf16_t* OC = (const bf16_t*)(ws + WS_OCMP);
    bf16_t* AO = (bf16_t*)(ws + WS_AO);
    int hio = hi, r32o = r32; asm volatile("" : "+v"(hio), "+v"(r32o));
#pragma unroll
    for (int r = 0; r < 16; ++r) { const size_t orow = (size_t)b * SEQ + t0 + 32 * (wid >> 2) + crow(r, hio);
        const float c0 = bf2f(OC[orow * 512 + head * 64 + r32o]), c1 = bf2f(OC[orow * 512 + head * 64 + 32 + r32o]);
        AO[orow * DM + head * 64 + r32o] = (bf16_t)(cvt_pk_bf16(res0[r] + c0, 0.f) & 0xffffu);
        AO[orow * DM + head * 64 + 32 + r32o] = (bf16_t)(cvt_pk_bf16(res1[r] + c1, 0.f) & 0xffffu); }
}
__device__ __forceinline__ void dsa_unit(const Args& a, LAS unsigned char* lds, int b, int h, int qb) {
    unsigned char* ws = a.ws;
    int tid_ = threadIdx.x; asm volatile("" : "+v"(tid_));
    const int tid = tid_, lane = tid & 63, wid = __builtin_amdgcn_readfirstlane(tid >> 6), r32 = lane & 31, hi = lane >> 5;
    const int t0 = qb * 256, t = t0 + 32 * wid + r32;
    const size_t trow = (size_t)b * SEQ + t;
    const bf16_t* Qd = (const bf16_t*)(ws + WS_QD) + trow * 512 + h * 64;
    bf16x8 qr[4];
#pragma unroll
    for (int d0 = 0; d0 < 4; ++d0) qr[d0] = *(const bf16x8*)(Qd + d0 * 16 + hi * 8);
    const u64* mrow = (const u64*)(ws + WS_MASKD) + trow * 32;
    const f32x16 z = (f32x16){0.f, 0.f, 0.f, 0.f, 0.f, 0.f, 0.f, 0.f, 0.f, 0.f, 0.f, 0.f, 0.f, 0.f, 0.f, 0.f};
    float m = 0.f, l = 0.f; f32x16 o0 = z, o1 = z;
    const size_t kbase = (size_t)b * SEQ * 512 + h * 64;
    flash_pass<2>(lds, (const bf16_t*)(ws + WS_KD) + kbase, (const bf16_t*)(ws + WS_VD) + (size_t)(b * 8 + h) * 32 * 4096, 512, 0, 4 * qb + 3, qr, t, t0 + 32 * wid, 4 * qb + (wid >> 1), 0u, mrow, m, l, o0, o1);
    const float f = 1.0f / swap_sum(l); float fr[16]; row_factors(lds, f, fr);
    bf16_t* AO = (bf16_t*)(ws + WS_AO);
    int hio = hi, r32o = r32; asm volatile("" : "+v"(hio), "+v"(r32o));
#pragma unroll
    for (int r = 0; r < 16; ++r) { const size_t orow = (size_t)b * SEQ + t0 + 32 * wid + crow(r, hio);
        AO[orow * DM + 512 + h * 64 + r32o] = (bf16_t)(cvt_pk_bf16(o0[r] * fr[r], 0.f) & 0xffffu);
        AO[orow * DM + 512 + h * 64 + 32 + r32o] = (bf16_t)(cvt_pk_bf16(o1[r] * fr[r], 0.f) & 0xffffu); }
}
}

__device__ __forceinline__ void p7_mid(const Args& a) {
    unsigned char* ws = a.ws; const float* mod = (const float*)(ws + WS_MOD);
    const int lane = threadIdx.x & 63, gw = blockIdx.x * 8 + (threadIdx.x >> 6), NGW = gridDim.x * 8;
    f32x4 xv[2][4], xn[2][4]; u32x2 yv[2][4], yn[2][4]; float sv[2], sn[2];
#define P7_LOAD(X, Y, S, row) do { const f32x4* xr_ = (const f32x4*)(a.in[I_X] + (size_t)(row) * DM) + lane; const u32x2* yr_ = (const u32x2*)((const bf16_t*)(ws + WS_Y) + (size_t)(row) * DM) + lane; \
        _Pragma("unroll") for (int j = 0; j < 4; ++j) { X[j] = __builtin_nontemporal_load(xr_ + 64 * j); Y[j] = yr_[64 * j]; } S = (lane < 32) ? ((const float*)(ws + WS_SSQY))[(size_t)(row) * 32 + lane] : 0.f; } while (0)
#pragma unroll
    for (int u = 0; u < 2; ++u) { const int row = min(gw + u * NGW, MTOK - 1); P7_LOAD(xv[u], yv[u], sv[u], row); }
#pragma unroll 1
    for (int row0 = gw; row0 < MTOK; row0 += 2 * NGW) {
#pragma unroll
        for (int u = 0; u < 2; ++u) { const int row = min(row0 + (2 + u) * NGW, MTOK - 1); P7_LOAD(xn[u], yn[u], sn[u], row); }
#pragma unroll
        for (int u = 0; u < 2; ++u) {
            const int row = row0 + u * NGW;
            if (row < MTOK) {
                const int b = row >> 11;
                const float rstd_y = 1.0f / sqrtf(wave_sum(sv[u]) * (1.f / DM) + EPS);
                f32x4 x1[4]; float s2 = 0.f;
#pragma unroll
                for (int j = 0; j < 4; ++j) { const int c = 256 * j + 4 * lane;
                    const f32x4 gq = *(const f32x4*)(a.in[I_GQM] + c), ga = *(const f32x4*)(mod + (size_t)b * 6144 + 2048 + c);
                    const float yf[4] = {bflo(yv[u][j].x), bfhi(yv[u][j].x), bflo(yv[u][j].y), bfhi(yv[u][j].y)};
#pragma unroll
                    for (int e = 0; e < 4; ++e) { x1[j][e] = xv[u][j][e] + ga[e] * (yf[e] * rstd_y * gq[e]); s2 += x1[j][e] * x1[j][e]; }
                    }
                const float rstd = 1.0f / sqrtf(wave_sum(s2) * (1.f / DM) + EPS);
                u32x2* o = (u32x2*)((bf16_t*)(ws + WS_H) + (size_t)row * DM) + lane;
#pragma unroll
                for (int j = 0; j < 4; ++j) { const int c = 256 * j + 4 * lane;
                    const f32x4 g = *(const f32x4*)(a.in[I_GPF] + c), sh = *(const f32x4*)(mod + (size_t)b * 6144 + 3072 + c), sc = *(const f32x4*)(mod + (size_t)b * 6144 + 4096 + c);
                    float h[4];
#pragma unroll
                    for (int e = 0; e < 4; ++e) h[e] = (x1[j][e] * rstd * g[e]) * (1.f + sc[e]) + sh[e];
                    o[64 * j] = (u32x2){cvt_pk_bf16(h[0], h[1]), cvt_pk_bf16(h[2], h[3])}; }
            }
        }
#pragma unroll
        for (int u = 0; u < 2; ++u) { sv[u] = sn[u];
#pragma unroll
            for (int j = 0; j < 4; ++j) { xv[u][j] = xn[u][j]; yv[u][j] = yn[u][j]; } }
    }
#undef P7_LOAD
}
__device__ __forceinline__ void p10_final(const Args& a) {
    unsigned char* ws = a.ws; const float* mod = (const float*)(ws + WS_MOD);
    const int lane = threadIdx.x & 63, gw = blockIdx.x * 8 + (threadIdx.x >> 6), NGW = gridDim.x * 8;
    f32x4 xv[2][4], xn[2][4]; u32x2 yv[2][4], yn[2][4], zv[2][4], zn[2][4]; float sy[2], syn[2], sz[2], szn[2];
#define P10_LOAD(X, Y, Z, SY, SZ, row) do { const f32x4* xr_ = (const f32x4*)(a.in[I_X] + (size_t)(row) * DM) + lane; const u32x2* yr_ = (const u32x2*)((const bf16_t*)(ws + WS_Y) + (size_t)(row) * DM) + lane; \
        const u32x2* zr_ = (const u32x2*)((const bf16_t*)(ws + WS_Z) + (size_t)(row) * DM) + lane; \
        _Pragma("unroll") for (int j = 0; j < 4; ++j) { X[j] = __builtin_nontemporal_load(xr_ + 64 * j); Y[j] = yr_[64 * j]; Z[j] = zr_[64 * j]; } \
        SY = (lane < 32) ? ((const float*)(ws + WS_SSQY))[(size_t)(row) * 32 + lane] : 0.f; SZ = (lane < 32) ? ((const float*)(ws + WS_SSQZ))[(size_t)(row) * 32 + lane] : 0.f; } while (0)
#pragma unroll
    for (int u = 0; u < 2; ++u) { const int row = min(gw + u * NGW, MTOK - 1); P10_LOAD(xv[u], yv[u], zv[u], sy[u], sz[u], row); }
#pragma unroll 1
    for (int row0 = gw; row0 < MTOK; row0 += 2 * NGW) {
#pragma unroll
        for (int u = 0; u < 2; ++u) { const int row = min(row0 + (2 + u) * NGW, MTOK - 1); P10_LOAD(xn[u], yn[u], zn[u], syn[u], szn[u], row); }
#pragma unroll
        for (int u = 0; u < 2; ++u) {
            const int row = row0 + u * NGW;
            if (row < MTOK) {
                const int b = row >> 11;
                const float rstd_y = 1.0f / sqrtf(wave_sum(sy[u]) * (1.f / DM) + EPS);
                const float rstd_z = 1.0f / sqrtf(wave_sum(sz[u]) * (1.f / DM) + EPS);
                f32x4* orow = (f32x4*)(a.out + (size_t)row * DM) + lane;
#pragma unroll
                for (int j = 0; j < 4; ++j) { const int c = 256 * j + 4 * lane;
                    const f32x4 gq = *(const f32x4*)(a.in[I_GQM] + c), ga = *(const f32x4*)(mod + (size_t)b * 6144 + 2048 + c);
                    const f32x4 gqf = *(const f32x4*)(a.in[I_GQF] + c), gaf = *(const f32x4*)(mod + (size_t)b * 6144 + 5120 + c);
                    const float yf[4] = {bflo(yv[u][j].x), bfhi(yv[u][j].x), bflo(yv[u][j].y), bfhi(yv[u][j].y)};
                    const float zf[4] = {bflo(zv[u][j].x), bfhi(zv[u][j].x), bflo(zv[u][j].y), bfhi(zv[u][j].y)};
                    f32x4 xo;
#pragma unroll
                    for (int e = 0; e < 4; ++e) { const float x1 = xv[u][j][e] + ga[e] * (yf[e] * rstd_y * gq[e]); xo[e] = x1 + gaf[e] * (zf[e] * rstd_z * gqf[e]); }
                    orow[64 * j] = xo; }
            }
        }
#pragma unroll
        for (int u = 0; u < 2; ++u) { sy[u] = syn[u]; sz[u] = szn[u];
#pragma unroll
            for (int j = 0; j < 4; ++j) { xv[u][j] = xn[u][j]; yv[u][j] = yn[u][j]; zv[u][j] = zn[u][j]; } }
    }
#undef P10_LOAD
}

__device__ __forceinline__ int queue_next(unsigned* head, volatile LAS unsigned* slot) {
    if (threadIdx.x == 0) *slot = __hip_atomic_fetch_add(head, 1u, __ATOMIC_RELAXED, __HIP_MEMORY_SCOPE_AGENT);
    __syncthreads();
    const int u = (int)*slot;
    __syncthreads();
    return u;
}

#ifndef MK_NVGPR
#define MK_NVGPR 256
#endif
__global__ void __launch_bounds__(512, 2) __attribute__((amdgpu_num_vgpr(MK_NVGPR))) mk_fwd(Args args) {
    extern __shared__ __attribute__((aligned(16))) unsigned char lds_raw[];
    LAS unsigned char* lds = (LAS unsigned char*)lds_raw;
    volatile LAS unsigned* MISC = (volatile LAS unsigned*)(lds + MISC_OFF);
    const int tid = threadIdx.x, G = gridDim.x, blk = blockIdx.x;
    unsigned char* ws = args.ws;
    unsigned* ctl = (unsigned*)(ws + WS_CTL);
    if (tid < 64) MISC[tid] = 0u;
    __syncthreads();
    XcdBarrier bar; bar.bar = ctl + CW_BAR + args.li * XCD_BAR_WORDS; bar.x = 0; bar.st = nullptr;
    if (MK_N_LAUNCHES != NPH) bar = xcd_barrier_post(ctl + CW_BAR + args.li * XCD_BAR_WORDS, MISC + 8);
    const int lo = args.ph_lo, hi = args.ph_hi;
#ifndef MK_PHASE_MASK
#define MK_PHASE_MASK 0xffffu
#endif
#ifndef MK_REPEAT_MASK
#define MK_REPEAT_MASK 0u
#endif
#define REP(k) for (int rep_ = 0; rep_ < (((MK_REPEAT_MASK >> (k)) & 1u) ? 2 : 1); ++rep_)
#define IN(k) ((MK_PHASE_MASK >> (k)) & 1u) && (lo <= (k) && (k) < hi)
#define SEAM(k) do { if (IN(k) && IN((k) + 1)) xcd_barrier(bar); } while (0)

    if (IN(0)) { REP(0) p0_prologue(args, lds); } SEAM(0);
    if (IN(1)) { REP(1) p1_hnorm(args); } SEAM(1);
    if (IN(2)) REP(2) {
        pg8::Gemm g{(const bf16_t*)(ws + WS_H), (const bf16_t*)(ws + WS_WIN), MTOK, NPROJ, DM, DM}; pg8::StaticOrder S; S.init(MTOK, NPROJ, G, blk);
        pg8::EpiInProj E{ws};
        pg8::gemm_phase<pg8::EpiInProj, pg8::StaticOrder, true>(lds, g, S, E);
    } SEAM(2);
    if (IN(3)) {
#ifndef MK_P3
#define MK_P3 7
#endif
        REP(11) {
        if ((MK_P3 & 1) && blk < 32) {
            const int kv = blk >> 4, pm = blk & 15;
            { pg8::Gemm g{(const bf16_t*)(ws + WS_KCR + (size_t)kv * PLANE_BUF), (const bf16_t*)(ws + WS_WC1) + (size_t)kv * 256 * 2048, 4096, 256, 2048, 1024};
              pg8::OneUnit S{pm, true}; pg8::EpiHid E{(bf16_t*)(ws + WS_HID) + (size_t)kv * 4096 * 256, (const float*)(ws + WS_B1P) + kv * 256};
              pg8::gemm_phase<pg8::EpiHid, pg8::OneUnit, false>(lds, g, S, E); }
            __builtin_amdgcn_fence(__ATOMIC_ACQUIRE, "agent"); asm volatile("s_waitcnt vmcnt(0)" ::: "memory"); __syncthreads();
            { pg8::Gemm g{(const bf16_t*)(ws + WS_HID) + (size_t)kv * 4096 * 256, (const bf16_t*)(ws + WS_WC2) + (size_t)kv * 256 * 256, 4096, 256, 256, 256};
              pg8::OneUnit S{pm, true}; pg8::EpiCmp E{ws, args.in[I_CB2] + kv * 64, kv};
              pg8::gemm_phase<pg8::EpiCmp, pg8::OneUnit, false>(lds, g, S, E); }
        }
        if (MK_P3 & 2) { pg8::Gemm g{(const bf16_t*)(ws + WS_CRAW), (const bf16_t*)(ws + WS_WKV), MTOK, 1024, 256, 256}; pg8::StaticOrder S; S.init(MTOK, 1024, G, blk);
          pg8::EpiKvGen E{ws};
          pg8::gemm_phase<pg8::EpiKvGen, pg8::StaticOrder, true>(lds, g, S, E); }
        }
        if (MK_P3 & 4) REP(3) for (;;) { const int u = queue_next(ctl + CW_Q_IDX + 256 * rep_, MISC + 4); if (u >= 2048) break; idx_unit(args, lds, u & 15, 127 - (u >> 4)); }
    } SEAM(3);
    if (IN(4)) {
        REP(4) {
            int cur_plane = -1;
            for (int u = blk; u < 1024; u += G) {
                const int plane = u & 31;
                if (plane != cur_plane) {
                    cur_plane = plane;
                    const bf16_t* KCg = (const bf16_t*)(ws + WS_KC) + (size_t)plane * 128 * 64;
                    const bf16_t* VTg = (const bf16_t*)(ws + WS_VCT) + (size_t)plane * 64 * 128;
                    __syncthreads();
                    for (int c = tid; c < 1024; c += 512) { const int n = c >> 3, ch = c & 7; *(LAS u32x4*)(lds + CMP_KC_OFF + n * CMP_KC_STR + ch * 16) = *(const u32x4*)(KCg + n * 64 + ch * 8); }
                    for (int c = tid; c < 1024; c += 512) { const int dd = c >> 4, ch = c & 15; const u32x4 v = *(const u32x4*)(VTg + dd * 128 + ch * 8);
                        LAS unsigned char* q = lds + CMP_VT_OFF + dd * CMP_VT_STR + ch * 16; *(LAS u32x2*)q = (u32x2){v.x, v.y}; *(LAS u32x2*)(q + 8) = (u32x2){v.z, v.w}; }
                    __syncthreads();
                }
                cmp_unit(args, lds, plane, u >> 5);
            }
        }
    } SEAM(4);
    if (IN(5)) {
        if (threadIdx.x >= 256) __builtin_amdgcn_s_setprio(1);
        REP(5) for (;;) { const int u = queue_next(ctl + CW_Q_FLASH + 256 * rep_, MISC + 4); if (u >= 2048) break;
            const int qb = 7 - (u >> 8), v = u & 255;
            if (v >= 32 && v < 160) { const int w = v - 32; fa::dsa_unit(args, lds, w >> 3, w & 7, qb); }
            else { const int s4 = (v < 32) ? 0 : ((v - 128) >> 5);
                   fa::nsa_unit(args, lds, v & 31, 4 * qb + 3 - s4); }
        }
        __builtin_amdgcn_s_setprio(0);
    } SEAM(5);
    if (IN(6)) REP(6) {
        pg8::Gemm g{(const bf16_t*)(ws + WS_AO), (const bf16_t*)(ws + WS_WOUT), MTOK, DM, DM, DM}; pg8::StaticOrder S; S.init(MTOK, DM, G, blk);
        pg8::EpiY E{(bf16_t*)(ws + WS_Y), (float*)(ws + WS_SSQY)};
        pg8::gemm_phase<pg8::EpiY, pg8::StaticOrder, true>(lds, g, S, E);
    } SEAM(6);
    if (IN(7)) { REP(7) p7_mid(args); } SEAM(7);
    if (IN(8)) REP(8) {
        pg8::Gemm g{(const bf16_t*)(ws + WS_H), (const bf16_t*)(ws + WS_WGU), MTOK, NGU, DM, DM}; pg8::StaticOrder S; S.init(MTOK, NGU, G, blk);
        pg8::EpiSwiglu E{(bf16_t*)(ws + WS_ACT)};
        pg8::gemm_phase<pg8::EpiSwiglu, pg8::StaticOrder, true>(lds, g, S, E);
    } SEAM(8);
    if (IN(9)) REP(9) {
        pg8::Gemm g{(const bf16_t*)(ws + WS_ACT), (const bf16_t*)(ws + WS_WDN), MTOK, DM, DFF, DFF}; pg8::StaticOrder S; S.init(MTOK, DM, G, blk);
        pg8::EpiY E{(bf16_t*)(ws + WS_Z), (float*)(ws + WS_SSQZ)};
        pg8::gemm_phase<pg8::EpiY, pg8::StaticOrder, true>(lds, g, S, E);
    } SEAM(9);
    if (IN(10)) { p10_final(args); }
#undef IN
#undef SEAM
}

extern "C" void kernel_launch(void* const* d_in, const int* in_sizes, int n_in, void* d_out, int out_size, void* d_ws, size_t ws_size, hipStream_t stream) {
    static int grid = 0;
    if (grid == 0) {
        if (n_in != 20 || in_sizes[0] != MTOK * DM || out_size != MTOK * DM || ws_size < WS_END) {
            fprintf(stderr, "kernel_launch: unexpected shapes (n_in %d, in0 %d, out %d, ws %zu; need ws >= %zu); nothing launched\n", n_in, n_in > 0 ? in_sizes[0] : -1, out_size, ws_size, (size_t)WS_END); grid = -1; return; }
        int dev = 0, cus = 0, per_cu = 0;
        if (hipGetDevice(&dev) != hipSuccess || hipDeviceGetAttribute(&cus, hipDeviceAttributeMultiprocessorCount, dev) != hipSuccess) { fprintf(stderr, "kernel_launch: device query failed\n"); grid = -1; return; }
        if (hipFuncSetAttribute((const void*)mk_fwd, hipFuncAttributeMaxDynamicSharedMemorySize, LDS_BYTES) != hipSuccess) { fprintf(stderr, "kernel_launch: hipFuncSetAttribute failed\n"); grid = -1; return; }
        if (hipOccupancyMaxActiveBlocksPerMultiprocessor(&per_cu, (const void*)mk_fwd, 512, LDS_BYTES) != hipSuccess || per_cu < 1)
            fprintf(stderr, "kernel_launch: note: occupancy query reports %d workgroups per CU\n", per_cu);
        (void)hipGetLastError();
        grid = cus;
    }
    if (grid < 0) return;
    if (hipMemsetAsync((char*)d_ws + WS_CTL, 0, CTL_ZERO_BYTES, stream) != hipSuccess) { fprintf(stderr, "kernel_launch: memset failed\n"); return; }
    Args a{};
    for (int i = 0; i < 20; ++i) a.in[i] = (const float*)d_in[i];
    a.out = (float*)d_out; a.ws = (unsigned char*)d_ws; a.pad = 0;
#if MK_N_LAUNCHES == 1
    a.ph_lo = 0; a.ph_hi = NPH; a.li = 0;
    hipLaunchKernelGGL(mk_fwd, dim3(grid), dim3(512), LDS_BYTES, stream, a);
#else
#ifndef MK_HOST_REP
#define MK_HOST_REP -1
#endif
    for (int li = 0; li < NPH; ++li) { a.ph_lo = li; a.ph_hi = li + 1; a.li = 0; hipLaunchKernelGGL(mk_fwd, dim3(grid), dim3(512), LDS_BYTES, stream, a);
        if (li == MK_HOST_REP) hipLaunchKernelGGL(mk_fwd, dim3(grid), dim3(512), LDS_BYTES, stream, a); }
#endif
    const hipError_t le = hipPeekAtLastError();
    if (le != hipSuccess) fprintf(stderr, "kernel_launch: launch failed: %s\n", hipGetErrorName(le));
}
```

```cpp
#include <hip/hip_runtime.h>
#include <cstdio>
#include <cstdint>

#define LAS __attribute__((address_space(3)))
#define GAS __attribute__((address_space(1)))
typedef unsigned short bf16_t;
typedef short bf16x8 __attribute__((ext_vector_type(8)));
typedef short s16x4 __attribute__((ext_vector_type(4)));
typedef float f32x2 __attribute__((ext_vector_type(2)));
typedef float f32x4 __attribute__((ext_vector_type(4)));
typedef float f32x16 __attribute__((ext_vector_type(16)));
typedef unsigned u32x2 __attribute__((ext_vector_type(2)));
typedef unsigned u32x4 __attribute__((ext_vector_type(4)));
typedef unsigned long long u64;

#ifndef MK_N_LAUNCHES
#define MK_N_LAUNCHES 1
#endif

constexpr int NB = 16, SEQ = 2048, DM = 1024, MTOK = NB * SEQ;
constexpr int NPROJ = 2560, DFF = 2816, NGU = 2 * DFF;
constexpr float EPS = 1e-6f;
constexpr float C2 = 0.125f * 1.4426950408889634f;
constexpr float NEGBIG = -1e30f;
constexpr int NPH = 11;

constexpr size_t MiB = 1u << 20;
constexpr size_t WS_CTL = 0, CTL_ZERO_BYTES = 1 * MiB;
constexpr size_t WS_ROPE = 1 * MiB;
constexpr size_t WS_MOD = WS_ROPE + 128 * 1024;
constexpr size_t WS_B1P = WS_MOD + 384 * 1024;
constexpr size_t WS_B1PP = WS_B1P + 2048;
constexpr size_t WS_WIN = 2 * MiB, WS_WOUT = 7 * MiB, WS_WGU = 9 * MiB, WS_WDN = 20 * MiB, WS_WKV = 26 * MiB, WS_WC1 = 27 * MiB, WS_WC2 = 29 * MiB;
constexpr size_t WS_HID = 30 * MiB;
constexpr size_t WS_KC = 34 * MiB;
constexpr size_t WS_VCT = 34 * MiB + 512 * 1024;
constexpr size_t WS_SSQC = 35 * MiB;
constexpr size_t WS_BM = 35 * MiB + 512 * 1024;
constexpr size_t WS_SSQY = 36 * MiB;
constexpr size_t WS_H = 40 * MiB, WS_Y = 104 * MiB, WS_AO = 168 * MiB, WS_R4 = 232 * MiB;
constexpr size_t WS_QN = WS_R4, WS_QD = WS_R4 + 32 * MiB, WS_QI = WS_R4 + 64 * MiB, WS_KD = WS_R4 + 96 * MiB, WS_VD = WS_R4 + 128 * MiB, WS_OCMP = WS_R4 + 160 * MiB;
constexpr size_t WS_KCR = WS_R4 + 192 * MiB;
constexpr size_t PLANE_BUF = 8 * MiB;
constexpr size_t WS_CRAW = WS_R4 + 240 * MiB;
constexpr size_t WS_KI = WS_R4 + 256 * MiB, WS_KR = WS_R4 + 260 * MiB, WS_GT = WS_R4 + 261 * MiB, WS_WI = WS_R4 + 264 * MiB, WS_MASKD = WS_R4 + 265 * MiB;
constexpr size_t WS_ACT = WS_R4;
constexpr size_t WS_Z = WS_AO;
constexpr size_t WS_SSQZ = 506 * MiB;
constexpr size_t WS_END = 510 * MiB;
constexpr int CW_BAR = 4096;
constexpr int CW_Q_IDX = 64, CW_Q_FLASH = 128;

constexpr int LDS_BYTES = 147456;
constexpr int MISC_OFF = LDS_BYTES - 256;

__device__ __forceinline__ unsigned cvt_pk_bf16(float lo, float hi) { unsigned r; asm volatile("v_cvt_pk_bf16_f32 %0, %1, %2" : "=v"(r) : "v"(lo), "v"(hi)); return r; }
__device__ __forceinline__ float bf2f(unsigned short h) { return __uint_as_float(((unsigned)h) << 16); }
__device__ __forceinline__ float bflo(unsigned w) { return __uint_as_float(w << 16); }
__device__ __forceinline__ float bfhi(unsigned w) { return __uint_as_float(w & 0xffff0000u); }
__device__ __forceinline__ u32x4 pack8(const float (&v)[8]) { u32x4 w; w.x = cvt_pk_bf16(v[0], v[1]); w.y = cvt_pk_bf16(v[2], v[3]); w.z = cvt_pk_bf16(v[4], v[5]); w.w = cvt_pk_bf16(v[6], v[7]); return w; }
__device__ __forceinline__ float fast_rcp(float x) { return __builtin_amdgcn_rcpf(x); }
__device__ __forceinline__ float fast_exp2(float x) { return __builtin_amdgcn_exp2f(x); }
__device__ __forceinline__ float swap_max(float v) { auto rr = __builtin_amdgcn_permlane32_swap(__float_as_uint(v), __float_as_uint(v), false, false); return fmaxf(__uint_as_float(rr[0]), __uint_as_float(rr[1])); }
__device__ __forceinline__ float swap_sum(float v) { auto rr = __builtin_amdgcn_permlane32_swap(__float_as_uint(v), __float_as_uint(v), false, false); return __uint_as_float(rr[0]) + __uint_as_float(rr[1]); }
__device__ __forceinline__ float max3f(float a, float b, float c) { float r; asm("v_max3_f32 %0, %1, %2, %3" : "=v"(r) : "v"(a), "v"(b), "v"(c)); return r; }
__device__ __forceinline__ float quad_xor1(float x) { return __int_as_float(__builtin_amdgcn_update_dpp(0, __float_as_int(x), 0xB1, 0xF, 0xF, true)); }
__device__ __forceinline__ float quad_xor2(float x) { return __int_as_float(__builtin_amdgcn_update_dpp(0, __float_as_int(x), 0x4E, 0xF, 0xF, true)); }
__device__ __forceinline__ float relu1(float x) { float r; asm("v_max_f32_e32 %0, 0, %1" : "=v"(r) : "v"(x)); return r; }
typedef __bf16 bf16x2_t __attribute__((ext_vector_type(2)));
__device__ __forceinline__ unsigned cvtpk_s(float lo, float hi) { f32x2 v = {lo, hi}; bf16x2_t b = __builtin_convertvector(v, bf16x2_t); return __builtin_bit_cast(unsigned, b); }
__device__ __forceinline__ int crow(int r, int hi) { return (r & 3) + 8 * (r >> 2) + 4 * hi; }
__device__ __forceinline__ float wave_sum(float v) {
#pragma unroll
    for (int o = 1; o < 64; o <<= 1) v += __shfl_xor(v, o);
    return v;
}

namespace pg8 {
constexpr int BM = 256, BK = 64, HALF = 128, HTB = HALF * BK * 2, STAGE_BYTES = 8 * HTB, NXCD = 8, WGM = 8;
__host__ __device__ __forceinline__ int lds_byte(int r, int c) { const int st = (r >> 4) * 2 + (c >> 5), rr = r & 15, cc = c & 31, ob = rr * 64 + cc * 2; return st * 1024 + (ob ^ (((ob >> 9) & 1) << 5)); }
__host__ __device__ __forceinline__ void stage_rc(int b, int& R, int& C) { const int st = b / 1024, sb = b % 1024, swz = sb ^ (((sb >> 9) & 1) << 5); R = (st >> 1) * 16 + swz / 64; C = (st & 1) * 32 + (swz % 64) / 2; }
__host__ __device__ __forceinline__ int perm32(int rho) { const int n = rho >> 4, i = rho & 15; return 8 * (i >> 2) + 4 * n + (i & 3); }

struct Unit { int pm, pn; };
struct Gemm { const bf16_t* A; const bf16_t* Bt; int M, N, K, lda; };

struct StaticOrder {
    int nM, nN, nwg, G, c;
    __host__ __device__ void init(int M, int N, int G_, int c_) { nM = M / BM; nN = N / BM; nwg = nM * nN; G = G_; c = c_; }
    __host__ __device__ bool next(int i, Unit& u) const {
        const long L = (long)i * G + c; if (L >= nwg) return false;
        int wgid = (int)L; { const int q = nwg / NXCD, r = nwg % NXCD, xcd = wgid % NXCD, off = wgid / NXCD; wgid = (xcd < r ? xcd * (q + 1) : r * (q + 1) + (xcd - r) * q) + off; }
        const int nig = WGM * nN, gid = wgid / nig, fm = gid * WGM, gsz = (nM - fm) < WGM ? (nM - fm) : WGM;
        u.pm = fm + ((wgid % nig) % gsz); u.pn = (wgid % nig) / gsz; return true;
    }
};
struct OneUnit {
    int pm; bool on;
    __device__ bool next(int i, Unit& u) const { if (i > 0 || !on) return false; u.pm = pm; u.pn = 0; return true; }
};

template <class Epi, class Sched, bool ALIGN_EPI>
__device__ __forceinline__ void gemm_phase(LAS unsigned char* lds, const Gemm g, const Sched& S, const Epi& E) {
    const int tid = threadIdx.x, wid = __builtin_amdgcn_readfirstlane(tid >> 6), lane = tid & 63, wr = wid >> 2, wc = wid & 3, fr = lane & 15, fq = lane >> 4;
    int K_ = g.K, lda_ = g.lda; asm volatile("" : "+s"(K_), "+s"(lda_));
    const int K = K_, nt = K / BK, lda = lda_;
    unsigned voffA[2], voffB[2];
#pragma unroll
    for (int i = 0; i < 2; ++i) { int R, C; stage_rc(tid * 16 + i * 8192, R, C); const int Rb = (R & ~31) + perm32(R & 31);
        voffA[i] = (unsigned)(R * lda + C) * 2u; voffB[i] = (unsigned)(Rb * K + C) * 2u; }
    const size_t kstep = (size_t)(BK * 2);
    const size_t hstepA = (size_t)HALF * lda * 2, hstepB = (size_t)HALF * K * 2;
    const size_t tstepA = 2 * hstepA, tstepB = 2 * hstepB;
    const unsigned ldsw = (unsigned)wid * 1024u;
    const int aoff = lds_byte(wr * 64 + fr, fq * 8), boff = lds_byte(wc * 32 + fr, fq * 8);
#define PG8_SA(b, h) (((b) * 2 + (h)) * HTB)
#define PG8_SB(b, h) ((4 + (b) * 2 + (h)) * HTB)
#define PG8_STAGE(bufoff, gbase, voff) do { _Pragma("unroll") for (int _i = 0; _i < 2; ++_i) \
        __builtin_amdgcn_global_load_lds((const unsigned*)((const char*)(gbase) + (voff)[_i]), (LAS unsigned*)(lds + (bufoff) + ldsw + _i * 8192), 16, 0, 0); } while (0)
#define PG8_LDA(dst, b, h) do { _Pragma("unroll") for (int m = 0; m < 4; ++m) _Pragma("unroll") for (int k = 0; k < 2; ++k) dst[m][k] = *(const LAS bf16x8*)(lds + PG8_SA(b, h) + aoff + m * 2048 + k * 1024); } while (0)
#define PG8_LDB(dst, b, h) do { _Pragma("unroll") for (int n = 0; n < 2; ++n) _Pragma("unroll") for (int k = 0; k < 2; ++k) dst[n][k] = *(const LAS bf16x8*)(lds + PG8_SB(b, h) + boff + n * 2048 + k * 1024); } while (0)
#define PG8_MMA(ai, bj, At, Bt) do { __builtin_amdgcn_s_setprio(1); _Pragma("unroll") for (int m = 0; m < 4; ++m) _Pragma("unroll") for (int n = 0; n < 2; ++n) _Pragma("unroll") for (int k = 0; k < 2; ++k) \
        acc[ai][bj][m][n] = __builtin_amdgcn_mfma_f32_16x16x32_bf16(Bt[n][k], At[m][k], acc[ai][bj][m][n], 0, 0, 0); __builtin_amdgcn_s_setprio(0); } while (0)
#define PG8_WAIT_V(n) asm volatile("s_waitcnt vmcnt(" #n ")" ::: "memory")
#define PG8_WAIT_L(n) asm volatile("s_waitcnt lgkmcnt(" #n ")" ::: "memory")
#define PG8_BAR __builtin_amdgcn_s_barrier()
#define PG8_SCHED __builtin_amdgcn_sched_barrier(0)
    Unit cur, nxt; int ui = 0;
    if (!S.next(0, cur)) return;
    f32x4 acc[2][2][4][2];
#pragma unroll
    for (int a = 0; a < 2; ++a)
#pragma unroll
        for (int b = 0; b < 2; ++b)
#pragma unroll
            for (int m = 0; m < 4; ++m)
#pragma unroll
                for (int n = 0; n < 2; ++n) acc[a][b][m][n] = (f32x4){0.f, 0.f, 0.f, 0.f};
    bf16x8 At[4][2], B0[2][2], B1[2][2];
    const char* cA = (const char*)g.A + (size_t)cur.pm * tstepA; const char* cB = (const char*)g.Bt + (size_t)cur.pn * tstepB;
    PG8_STAGE(PG8_SB(0, 0), cB, voffB); PG8_STAGE(PG8_SB(0, 1), cB + hstepB, voffB); PG8_STAGE(PG8_SA(0, 0), cA, voffA); PG8_STAGE(PG8_SA(0, 1), cA + hstepA, voffA);
    if (wr == 1) PG8_BAR;
    PG8_WAIT_V(2); PG8_BAR;
    PG8_STAGE(PG8_SB(1, 0), cB + kstep, voffB); PG8_STAGE(PG8_SA(1, 0), cA + kstep, voffA); PG8_STAGE(PG8_SB(1, 1), cB + hstepB + kstep, voffB);
    PG8_WAIT_V(6); PG8_BAR;
    for (;;) {
        const bool has_next = S.next(ui + 1, nxt);
        const char* nA = has_next ? (const char*)g.A + (size_t)nxt.pm * tstepA : cA; const char* nB = has_next ? (const char*)g.Bt + (size_t)nxt.pn * tstepB : cB;
        for (int t = 0; t < nt; t += 2) {
            const bool last = (t == nt - 2);
            const char* a1 = cA + (size_t)(t + 1) * kstep;
            const char* a2 = last ? nA : cA + (size_t)(t + 2) * kstep; const char* b2 = last ? nB : cB + (size_t)(t + 2) * kstep;
            const char* a3 = a2 + kstep; const char* b3 = b2 + kstep;
            PG8_LDB(B0, 0, 0); PG8_LDB(B1, 0, 1); PG8_SCHED; PG8_LDA(At, 0, 0); PG8_STAGE(PG8_SA(1, 1), a1 + hstepA, voffA);
            PG8_WAIT_V(8); PG8_WAIT_L(0); PG8_BAR; PG8_MMA(0, 0, At, B0); PG8_MMA(0, 1, At, B1); PG8_BAR; PG8_SCHED;
            PG8_LDA(At, 0, 1); PG8_STAGE(PG8_SB(0, 0), b2, voffB); PG8_STAGE(PG8_SB(0, 1), b2 + hstepB, voffB); PG8_STAGE(PG8_SA(0, 0), a2, voffA);
            PG8_WAIT_V(8); PG8_WAIT_L(0); PG8_BAR; PG8_MMA(1, 0, At, B0); PG8_MMA(1, 1, At, B1); PG8_BAR; PG8_SCHED;
            PG8_LDB(B0, 1, 0); PG8_LDB(B1, 1, 1); PG8_SCHED; PG8_LDA(At, 1, 0); PG8_STAGE(PG8_SA(0, 1), a2 + hstepA, voffA);
            PG8_WAIT_V(8); PG8_WAIT_L(0); PG8_BAR; PG8_MMA(0, 0, At, B0); PG8_MMA(0, 1, At, B1); PG8_BAR; PG8_SCHED;
            PG8_LDA(At, 1, 1); PG8_STAGE(PG8_SB(1, 0), b3, voffB); PG8_STAGE(PG8_SB(1, 1), b3 + hstepB, voffB); PG8_STAGE(PG8_SA(1, 0), a3, voffA);
            PG8_WAIT_V(8); PG8_WAIT_L(0); PG8_BAR; PG8_MMA(1, 0, At, B0); PG8_MMA(1, 1, At, B1); PG8_BAR; PG8_SCHED;
        }
        if constexpr (ALIGN_EPI) { if (wr == 0) PG8_BAR; }
        E(acc, cur, wr, wc, fr, fq);
        if (!has_next) break;
#pragma unroll
        for (int a = 0; a < 2; ++a)
#pragma unroll
            for (int b = 0; b < 2; ++b)
#pragma unroll
                for (int m = 0; m < 4; ++m)
#pragma unroll
                    for (int n = 0; n < 2; ++n) acc[a][b][m][n] = (f32x4){0.f, 0.f, 0.f, 0.f};
        cur = nxt; cA = nA; cB = nB; ++ui;
        if constexpr (ALIGN_EPI) { if (wr == 1) PG8_BAR; }
    }
    PG8_WAIT_V(0);
    if constexpr (!ALIGN_EPI) { if (wr == 0) PG8_BAR; }
    PG8_BAR;
#undef PG8_SA
#undef PG8_SB
#undef PG8_STAGE
#undef PG8_LDA
#undef PG8_LDB
#undef PG8_MMA
#undef PG8_WAIT_V
#undef PG8_WAIT_L
#undef PG8_BAR
#undef PG8_SCHED
}

#define EPI_ROWS_BEGIN _Pragma("unroll") for (int ai = 0; ai < 2; ++ai) _Pragma("unroll") for (int m = 0; m < 4; ++m) { const int row = u.pm * BM + ai * HALF + wr * 64 + m * 16 + fr;
#define EPI_ROWS_END asm volatile("" ::: "memory"); }
#define EPI_V8(v, ai, bj, m) float v[8] = {acc[ai][bj][m][0][0], acc[ai][bj][m][0][1], acc[ai][bj][m][0][2], acc[ai][bj][m][0][3], acc[ai][bj][m][1][0], acc[ai][bj][m][1][1], acc[ai][bj][m][1][2], acc[ai][bj][m][1][3]}

struct EpiInProj {
    unsigned char* ws;
    __device__ __forceinline__ void operator()(const f32x4 (&acc)[2][2][4][2], const Unit& u, int wr, int wc, int fr, int fq) const {
        const float* rope = (const float*)(ws + WS_ROPE);
#pragma unroll
        for (int bj = 0; bj < 2; ++bj) {
            const int seg = 2 * u.pn + bj;
            const int cl = wc * 32 + 8 * fq;
            const bool ropeseg = !(seg == 5 || seg == 7 || seg == 9 || seg == 14);
            const bool dorope = ropeseg && ((wc & 1) == 0);
            EPI_ROWS_BEGIN
                EPI_V8(v, ai, bj, m);
                if (dorope) {
                    float p[8];
#pragma unroll
                    for (int j = 0; j < 8; ++j) p[j] = __shfl_xor(v[j], 16);
                    if (fq < 2) {
                        const float* T = rope + (size_t)(row & (SEQ - 1)) * 16;
                        const f32x4 c0 = *(const f32x4*)T, c1 = *(const f32x4*)(T + 4), s0 = *(const f32x4*)(T + 8), s1 = *(const f32x4*)(T + 12);
                        const float cc[8] = {c0[0], c0[1], c0[2], c0[3], c1[0], c1[1], c1[2], c1[3]};
                        const float ss[8] = {s0[0], s0[1], s0[2], s0[3], s1[0], s1[1], s1[2], s1[3]};
                        const float sg = (fq == 0) ? -1.f : 1.f;
#pragma unroll
                        for (int j = 0; j < 8; ++j) v[j] = v[j] * cc[j] + sg * p[j] * ss[j];
                    }
                }
                if (seg < 4 || (seg >= 10 && seg < 14)) {
#pragma unroll
                    for (int j = 0; j < 8; ++j) v[j] *= C2;
                    bf16_t* base = (bf16_t*)(ws + (seg < 4 ? WS_QN : WS_QD));
                    const int sl = seg < 4 ? seg : seg - 10;
                    *(u32x4*)(base + (size_t)row * 512 + sl * 128 + cl) = pack8(v);
                } else if (seg >= 4 && seg < 10) {
                    bf16_t* base = (bf16_t*)(ws + WS_KCR + (size_t)(seg - 4) * PLANE_BUF);
                    const int g = cl >> 6, d = cl & 63;
                    const size_t prow = (size_t)row + (size_t)((row >> 11) + g) * SEQ;
                    if (seg == 7 || seg == 9) {
                        bf16_t* tp = base + (prow >> 6) * 4096 + (size_t)d * 64 + (prow & 63);
#pragma unroll
                        for (int j = 0; j < 8; ++j) tp[j * 64] = (bf16_t)(cvt_pk_bf16(v[j], 0.f) & 0xffffu);
                    } else {
                        *(u32x4*)(base + prow * 64 + d) = pack8(v);
                    }
                } else if (seg == 14) {
                    bf16_t* base = (bf16_t*)(ws + WS_CRAW);
                    *(u32x4*)(base + (size_t)row * 256 + cl) = pack8(v);
                    *(u32x4*)(base + (size_t)row * 256 + 128 + cl) = (u32x4){0u, 0u, 0u, 0u};
                    float s = 0.f;
#pragma unroll
                    for (int j = 0; j < 8; ++j) s += v[j] * v[j];
                    s += __shfl_xor(s, 16); s += __shfl_xor(s, 32);
                    if (fq == 0) ((float*)(ws + WS_SSQC))[(size_t)row * 4 + wc] = s;
                } else if (seg >= 15 && seg < 19) {
                    bf16_t* base = (bf16_t*)(ws + WS_QI);
                    *(u32x4*)(base + (size_t)row * 512 + (seg - 15) * 128 + cl) = pack8(v);
                } else {
                    if (cl < 64) { *(u32x4*)((bf16_t*)(ws + WS_KI) + (size_t)row * 64 + cl) = pack8(v); }
                    else if (cl < 80) { *(u32x4*)((bf16_t*)(ws + WS_KR) + (size_t)row * 16 + (cl - 64)) = pack8(v); }
                    else if (cl < 104) {
                        float* gp = (float*)(ws + WS_GT) + (size_t)row * 24 + (cl - 80);
                        f32x4 a, b;
                        a[0] = fast_rcp(1.f + __expf(-v[0])); a[1] = fast_rcp(1.f + __expf(-v[1])); a[2] = fast_rcp(1.f + __expf(-v[2])); a[3] = fast_rcp(1.f + __expf(-v[3]));
                        b[0] = fast_rcp(1.f + __expf(-v[4])); b[1] = fast_rcp(1.f + __expf(-v[5])); b[2] = fast_rcp(1.f + __expf(-v[6])); b[3] = fast_rcp(1.f + __expf(-v[7]));
                        *(f32x4*)gp = a; *(f32x4*)(gp + 4) = b;
                    } else if (cl < 112) {
                        const float sc = 0.35355339059327373f * 0.125f;
                        float* wp = (float*)(ws + WS_WI) + (size_t)row * 8;
                        *(f32x4*)wp = (f32x4){v[0] * sc, v[1] * sc, v[2] * sc, v[3] * sc}; *(f32x4*)(wp + 4) = (f32x4){v[4] * sc, v[5] * sc, v[6] * sc, v[7] * sc};
                    }
                }
            EPI_ROWS_END
        }
    }
};

struct EpiKvGen {
    unsigned char* ws;
    __device__ __forceinline__ void operator()(const f32x4 (&acc)[2][2][4][2], const Unit& u, int wr, int wc, int fr, int fq) const {
        const float* ssq = (const float*)(ws + WS_SSQC);
        const bf16_t* Kr = (const bf16_t*)(ws + WS_KR);
        EPI_ROWS_BEGIN
            const f32x4 q = *(const f32x4*)(ssq + (size_t)row * 4);
            const float rstd = 1.0f / sqrtf(((q[0] + q[1]) + (q[2] + q[3])) * (1.f / 128.f) + EPS);
#pragma unroll
            for (int bj = 0; bj < 2; ++bj) {
                const int col = u.pn * BM + bj * HALF + wc * 32 + 8 * fq;
                EPI_V8(v, ai, bj, m);
#pragma unroll
                for (int j = 0; j < 8; ++j) v[j] *= rstd;
                u32x4 w = pack8(v);
                if (col < 512) {
                    if ((col & 63) < 16) w = *(const u32x4*)(Kr + (size_t)row * 16 + (col & 63));
                    *(u32x4*)((bf16_t*)(ws + WS_KD) + (size_t)row * 512 + col) = w;
                } else {
                    const int hh = (col - 512) >> 6, d = col & 63, bb = row >> 11, sp = row & (SEQ - 1);
                    bf16_t* tp = (bf16_t*)(ws + WS_VD) + ((size_t)(bb * 8 + hh) * 32 + (sp >> 6)) * 4096 + (size_t)d * 64 + (sp & 63);
#pragma unroll
                    for (int j = 0; j < 8; ++j) tp[j * 64] = (bf16_t)(cvt_pk_bf16(v[j], 0.f) & 0xffffu);
                }
            }
        EPI_ROWS_END
    }
};

__device__ __forceinline__ float gelu_tanh(float x) {
    const float t = 0.7978845608028654f * (x + 0.044715f * x * x * x);
    const float e = __expf(2.f * t);
    const float th = 1.f - 2.f * fast_rcp(e + 1.f);
    return 0.5f * x * (1.f + th);
}
struct EpiHid {
    bf16_t* out; const float* bias;
    __device__ __forceinline__ void operator()(const f32x4 (&acc)[2][2][4][2], const Unit& u, int wr, int wc, int fr, int fq) const {
#pragma unroll
        for (int bj = 0; bj < 2; ++bj) {
            const int col = bj * HALF + wc * 32 + 8 * fq;
            const f32x4 b0 = *(const f32x4*)(bias + col), b1 = *(const f32x4*)(bias + col + 4);
            EPI_ROWS_BEGIN
                EPI_V8(v, ai, bj, m);
#pragma unroll
                for (int j = 0; j < 4; ++j) { v[j] = gelu_tanh(v[j] + b0[j]); v[4 + j] = gelu_tanh(v[4 + j] + b1[j]); }
                *(u32x4*)(out + (size_t)row * 256 + col) = pack8(v);
            EPI_ROWS_END
        }
    }
};
struct EpiCmp {
    unsigned char* ws; const float* b2; int kv;
    __device__ __forceinline__ void operator()(const f32x4 (&acc)[2][2][4][2], const Unit& u, int wr, int wc, int fr, int fq) const {
        const int col = wc * 32 + 8 * fq;
        if (col < 64) {
            const f32x4 b0 = *(const f32x4*)(b2 + col), b1 = *(const f32x4*)(b2 + col + 4);
            EPI_ROWS_BEGIN
                EPI_V8(v, ai, 0, m);
                const int n = row & 127;
#pragma unroll
                for (int j = 0; j < 4; ++j) { v[j] = (n == 127) ? 0.f : v[j] + b0[j]; v[4 + j] = (n == 127) ? 0.f : v[4 + j] + b1[j]; }
                if (kv == 0) { *(u32x4*)((bf16_t*)(ws + WS_KC) + (size_t)row * 64 + col) = pack8(v); }
                else { bf16_t* vt = (bf16_t*)(ws + WS_VCT) + (size_t)(row >> 7) * 64 * 128 + n;
#pragma unroll
                    for (int j = 0; j < 8; ++j) vt[(size_t)(col + j) * 128] = (bf16_t)(cvt_pk_bf16(v[j], 0.f) & 0xffffu); }
            EPI_ROWS_END
        }
    }
};
struct EpiY {
    bf16_t* out; float* ssq;
    __device__ __forceinline__ void operator()(const f32x4 (&acc)[2][2][4][2], const Unit& u, int wr, int wc, int fr, int fq) const {
#pragma unroll
        for (int bj = 0; bj < 2; ++bj) {
            const int col = u.pn * BM + bj * HALF + wc * 32 + 8 * fq;
            EPI_ROWS_BEGIN
                EPI_V8(v, ai, bj, m);
                float s = 0.f;
#pragma unroll
                for (int j = 0; j < 8; ++j) s += v[j] * v[j];
                s += __shfl_xor(s, 16); s += __shfl_xor(s, 32);
                if (fq == 0) ssq[(size_t)row * 32 + u.pn * 8 + bj * 4 + wc] = s;
                *(u32x4*)(out + (size_t)row * DM + col) = pack8(v);
            EPI_ROWS_END
        }
    }
};
struct EpiSwiglu {
    bf16_t* out;
    __device__ __forceinline__ void operator()(const f32x4 (&acc)[2][2][4][2], const Unit& u, int wr, int wc, int fr, int fq) const {
        const int col = u.pn * HALF + wc * 32 + 8 * fq;
        EPI_ROWS_BEGIN
            EPI_V8(g, ai, 0, m); EPI_V8(p, ai, 1, m);
            float v[8];
#pragma unroll
            for (int j = 0; j < 8; ++j) v[j] = g[j] * fast_rcp(1.f + __expf(-g[j])) * p[j];
            *(u32x4*)(out + (size_t)row * DFF + col) = pack8(v);
        EPI_ROWS_END
    }
};
}

#define XB_TMO      128
#define XB_XCNT(j)  (256  + 64 * (j))
#define XB_XSUB(j)  (1280 + 64 * (j))
#define XB_XGEN(j)  (2304 + 64 * (j))
#define XB_TOP      3328
#define XB_TOPGEN   3392
#define XCD_BAR_WORDS 3456
#define XB_SPIN_CAP (1u << 18)
__device__ __forceinline__ unsigned xb_ld(unsigned* p)              { return __hip_atomic_load(p, __ATOMIC_RELAXED, __HIP_MEMORY_SCOPE_AGENT); }
__device__ __forceinline__ unsigned xb_add(unsigned* p, unsigned v) { return __hip_atomic_fetch_add(p, v, __ATOMIC_RELAXED, __HIP_MEMORY_SCOPE_AGENT); }
__device__ __forceinline__ unsigned xb_xcc_id() { return (unsigned)__builtin_amdgcn_s_getreg((3 << 11) | 20) & 0xFu; }
#define XB_SPIN(cond, bar) do { unsigned _sp = 0; while (cond) { __builtin_amdgcn_s_sleep(1); \
    if ((++_sp & 255u) == 0u) { if (xb_ld(&(bar)[XB_TMO])) break; if (_sp > XB_SPIN_CAP) { atomicAdd(&(bar)[XB_TMO], 1u); break; } } } } while (0)
struct XcdBarrier { unsigned* bar; unsigned x; volatile LAS unsigned* st; };
__device__ __forceinline__ XcdBarrier xcd_barrier_post(unsigned* bar, volatile LAS unsigned* st) {
    XcdBarrier b; b.bar = bar; b.x = xb_xcc_id(); b.st = st;
    if (threadIdx.x == 0) (void)xb_add(&bar[XB_XCNT(b.x)], 1u);
    return b;
}
__device__ __forceinline__ void xcd_barrier_complete(unsigned* bar, unsigned x, unsigned& nloc, unsigned& nx) {
    const unsigned G = gridDim.x * gridDim.y * gridDim.z;
    unsigned sum, cnt, mine, sp = 0u;
    for (;;) {
        sum = 0u; cnt = 0u; mine = 0u;
#pragma unroll
        for (unsigned j = 0; j < 16; ++j) { const unsigned c = xb_ld(&bar[XB_XCNT(j)]); sum += c; cnt += (c > 0u) ? 1u : 0u; mine = (j == x) ? c : mine; }
        if (sum == G) break;
        __builtin_amdgcn_s_sleep(1);
        if ((++sp & 255u) == 0u) { if (xb_ld(&bar[XB_TMO])) break; if (sp > XB_SPIN_CAP) { atomicAdd(&bar[XB_TMO], 1u); break; } }
    }
    nloc = mine > 0u ? mine : 1u; nx = cnt > 0u ? cnt : 1u;
}
__device__ __forceinline__ void xcd_barrier(const XcdBarrier& b) {
    asm volatile("s_waitcnt vmcnt(0)" ::: "memory");
    __syncthreads();
    if (threadIdx.x == 0) {
        unsigned* bar = b.bar;
        __builtin_amdgcn_s_waitcnt(0);
        unsigned nloc = b.st[0], nx = b.st[1];
        if (nloc == 0u) { xcd_barrier_complete(bar, b.x, nloc, nx); b.st[0] = nloc; b.st[1] = nx; }
        const unsigned old = xb_add(&bar[XB_XSUB(b.x)], 1u);
        const unsigned gen = old / nloc;
        if (old + 1u == (gen + 1u) * nloc) {
            __builtin_amdgcn_fence(__ATOMIC_RELEASE, "agent");
            asm volatile("s_waitcnt vmcnt(0)" ::: "memory");
            const unsigned og = xb_add(&bar[XB_TOP], 1u);
            const unsigned tg = og / nx;
            if (og + 1u == (tg + 1u) * nx) xb_add(&bar[XB_TOPGEN], 1u);
            else XB_SPIN(xb_ld(&bar[XB_TOPGEN]) == tg, bar);
            __builtin_amdgcn_fence(__ATOMIC_ACQUIRE, "agent");
            xb_add(&bar[XB_XGEN(b.x)], 1u);
            asm volatile("s_waitcnt vmcnt(0)" ::: "memory");
        } else {
            XB_SPIN(xb_ld(&bar[XB_XGEN(b.x)]) == gen, bar);
            __builtin_amdgcn_fence(__ATOMIC_ACQUIRE, "agent");
            asm volatile("s_waitcnt vmcnt(0)" ::: "memory");
        }
    }
    __syncthreads();
}

struct Args { const float* in[20]; float* out; unsigned char* ws; int ph_lo, ph_hi, li, pad; };
enum { I_X = 0, I_C, I_WADA, I_BADA, I_GPM, I_GQM, I_GPF, I_GQF, I_WIN, I_PE, I_CW1, I_CB1, I_CW2, I_CB2, I_GKV, I_WUK, I_WUV, I_WOUT, I_WGU, I_WDN };

struct ColSrc { const float* p; int ld; int kmax; };
__device__ __forceinline__ ColSrc col_src(const Args& a, int mat, int n) {
    ColSrc c; c.p = nullptr; c.ld = 0; c.kmax = 1 << 30;
    switch (mat) {
    case 0: { int sc;
        if (n < 1280) sc = n; else if (n < 1920) sc = n + 24; else if (n < 2496) sc = n + 40; else if (n < 2512) sc = n - 552; else if (n < 2536) sc = n - 1232; else if (n < 2544) sc = n; else sc = -1;
        if (sc >= 0) c.p = a.in[I_WIN] + sc; c.ld = 2544; break; }
    case 1: c.p = a.in[I_WOUT] + n; c.ld = DM; break;
    case 2: { const int pn = n >> 8, jj = n & 255, bj = jj >> 7, col = pn * 128 + (jj & 127); c.p = a.in[I_WGU] + bj * DFF + col; c.ld = NGU; break; }
    case 3: c.p = a.in[I_WDN] + n; c.ld = DM; break;
    case 4: { c.kmax = 128;
        if (n < 512) { const int h = n >> 6, d = n & 63; if (d >= 16) c.p = a.in[I_WUK] + (size_t)h * 128 * 48 + (d - 16); c.ld = 48; }
        else { const int h = (n - 512) >> 6, d = n & 63; c.p = a.in[I_WUV] + (size_t)h * 128 * 64 + d; c.ld = 64; }
        break; }
    case 5: case 6: { if (n < 128) c.p = a.in[I_CW1] + (size_t)(mat - 5) * 2048 * 128 + n; c.ld = 128; break; }
    default: { c.kmax = 128; if (n < 64) c.p = a.in[I_CW2] + (size_t)(mat - 7) * 128 * 64 + n; c.ld = 64; break; }
    }
    return c;
}
__device__ __forceinline__ void p0_transpose_item(const Args& a, int mat, int K, bf16_t* WT, int kb, int nb, LAS float* scr, int lane) {
    const int k0 = 64 * kb, n0 = 32 * nb;
    const ColSrc c = col_src(a, mat, n0 + (lane & 31));
    const bool live = (c.p != nullptr) && (k0 < c.kmax);
    const float* p = live ? c.p + (size_t)(k0 + (lane >> 5)) * c.ld : a.in[I_GKV];
    const size_t step = live ? (size_t)2 * c.ld : 0;
    float v[32];
#pragma unroll
    for (int i = 0; i < 32; ++i) v[i] = p[(size_t)i * step];
    if (mat == 4) {
#pragma unroll
        for (int i = 0; i < 32; ++i) v[i] *= a.in[I_GKV][(k0 + 2 * i + (lane >> 5)) & 127];
    }
#pragma unroll
    for (int i = 0; i < 32; ++i) scr[(2 * i + (lane >> 5)) * 33 + (lane & 31)] = live ? v[i] : 0.f;
    asm volatile("s_waitcnt lgkmcnt(0)" ::: "memory");
    const int cc = lane & 7;
#pragma unroll
    for (int j = 0; j < 4; ++j) { const int n = (lane >> 3) + 8 * j; const LAS float* sp = scr + (8 * cc) * 33 + n;
        u32x4 o; o.x = cvt_pk_bf16(sp[0 * 33], sp[1 * 33]); o.y = cvt_pk_bf16(sp[2 * 33], sp[3 * 33]); o.z = cvt_pk_bf16(sp[4 * 33], sp[5 * 33]); o.w = cvt_pk_bf16(sp[6 * 33], sp[7 * 33]);
        *(u32x4*)(WT + (size_t)(n0 + n) * K + k0 + 8 * cc) = o; }
    asm volatile("s_waitcnt lgkmcnt(0)" ::: "memory");
}
__device__ __forceinline__ void p0_prologue(const Args& a, LAS unsigned char* lds) {
    unsigned char* ws = a.ws;
    const int tid = threadIdx.x, lane = tid & 63, wave = tid >> 6, G = gridDim.x, blk = blockIdx.x;
    __syncthreads();
    {
        LAS float* cact = (LAS float*)lds;
        LAS float* red = (LAS float*)(lds + 65536);
        for (int i = tid; i < NB * DM; i += 512) { const float c = a.in[I_C][i]; cact[i] = c * fast_rcp(1.f + __expf(-c)); }
        __syncthreads();
        for (int cb = blk; cb < 256; cb += G) {
            const int ks = tid >> 5, jj = tid & 31, col = cb * 24 + jj;
            float accv[16];
#pragma unroll
            for (int b = 0; b < 16; ++b) accv[b] = 0.f;
            if (jj < 24) {
#pragma unroll 1
                for (int k0 = ks * 64; k0 < ks * 64 + 64; k0 += 16) {
                    float wv[16];
#pragma unroll
                    for (int kk = 0; kk < 16; ++kk) wv[kk] = a.in[I_WADA][(size_t)(k0 + kk) * 6144 + col];
#pragma unroll
                    for (int kk = 0; kk < 16; ++kk)
#pragma unroll
                        for (int b = 0; b < 16; ++b) accv[b] += cact[b * DM + k0 + kk] * wv[kk];
                }
#pragma unroll
                for (int b = 0; b < 16; ++b) red[(ks * 16 + b) * 24 + jj] = accv[b];
            }
            __syncthreads();
            if (tid < 384) { const int b = tid / 24, j2 = tid % 24; float s = 0.f;
#pragma unroll
                for (int k2 = 0; k2 < 16; ++k2) s += red[(k2 * 16 + b) * 24 + j2];
                ((float*)(ws + WS_MOD))[(size_t)b * 6144 + cb * 24 + j2] = s + a.in[I_BADA][cb * 24 + j2]; }
            __syncthreads();
        }
    }
    if (blk < 32) {
        LAS float* red = (LAS float*)lds;
        const int kv = blk >> 4, ks = blk & 15, j = tid & 127, q = tid >> 7; float s = 0.f;
        const float* pe = a.in[I_PE] + (size_t)kv * 2048 + ks * 128 + q * 32;
        const float* w1 = a.in[I_CW1] + ((size_t)kv * 2048 + ks * 128 + q * 32) * 128 + j;
        float wv[32];
#pragma unroll
        for (int k = 0; k < 32; ++k) wv[k] = w1[(size_t)k * 128];
#pragma unroll
        for (int k = 0; k < 32; ++k) s += pe[k] * wv[k];
        red[tid] = s; __syncthreads();
        if (tid < 128) ((float*)(ws + WS_B1PP))[(kv * 16 + ks) * 128 + tid] = (red[tid] + red[tid + 128]) + (red[tid + 256] + red[tid + 384]);
        __syncthreads();
    }
    for (int e = blk * 512 + tid; e < SEQ * 8; e += G * 512) {
        const int pos = e >> 3, i = e & 7;
        const float inv = (float)exp(-(double)i * 0.125 * 13.122363377404328);
        const float ang = (float)pos * inv;
        double x = (double)ang; const double n = rint(x * 0.15915494309189535); x = x - n * 6.283185307179586;
        const double x2 = x * x;
        double s = 0.0, c = 0.0, ts = x, tc = 1.0;
#pragma unroll
        for (int q = 0; q < 14; ++q) { s += ts; c += tc; ts = -ts * x2 / (double)((2 * q + 2) * (2 * q + 3)); tc = -tc * x2 / (double)((2 * q + 1) * (2 * q + 2)); }
        ((float*)(ws + WS_ROPE))[pos * 16 + i] = (float)c; ((float*)(ws + WS_ROPE))[pos * 16 + 8 + i] = (float)s;
    }
    {
        LAS float* scr = (LAS float*)(lds + wave * 16384);
        const int gw = blk * 8 + wave, NGW = G * 8;
        constexpr int I0 = 16 * 80, I1 = 16 * 32, I2 = 16 * 176, I3 = 44 * 32, I4 = 4 * 32, I5 = 32 * 8, I7 = 4 * 8;
        constexpr int NIT = I0 + I1 + I2 + I3 + I4 + 2 * I5 + 2 * I7;
        for (int it = gw; it < NIT; it += NGW) {
            int r = it;
            if (r < I0) { p0_transpose_item(a, 0, 1024, (bf16_t*)(ws + WS_WIN), r / 80, r % 80, scr, lane); continue; } r -= I0;
            if (r < I1) { p0_transpose_item(a, 1, 1024, (bf16_t*)(ws + WS_WOUT), r / 32, r % 32, scr, lane); continue; } r -= I1;
            if (r < I2) { p0_transpose_item(a, 2, 1024, (bf16_t*)(ws + WS_WGU), r / 176, r % 176, scr, lane); continue; } r -= I2;
            if (r < I3) { p0_transpose_item(a, 3, 2816, (bf16_t*)(ws + WS_WDN), r / 32, r % 32, scr, lane); continue; } r -= I3;
            if (r < I4) { p0_transpose_item(a, 4, 256, (bf16_t*)(ws + WS_WKV), r / 32, r % 32, scr, lane); continue; } r -= I4;
            if (r < I5) { p0_transpose_item(a, 5, 2048, (bf16_t*)(ws + WS_WC1), r / 8, r % 8, scr, lane); continue; } r -= I5;
            if (r < I5) { p0_transpose_item(a, 6, 2048, (bf16_t*)(ws + WS_WC1) + 256 * 2048, r / 8, r % 8, scr, lane); continue; } r -= I5;
            if (r < I7) { p0_transpose_item(a, 7, 256, (bf16_t*)(ws + WS_WC2), r / 8, r % 8, scr, lane); continue; } r -= I7;
            p0_transpose_item(a, 8, 256, (bf16_t*)(ws + WS_WC2) + 256 * 256, r / 8, r % 8, scr, lane);
        }
    }
}

__device__ __forceinline__ void p1_hnorm(const Args& a) {
    unsigned char* ws = a.ws; const float* mod = (const float*)(ws + WS_MOD);
    if (blockIdx.x == 0 && threadIdx.x < 256) {
        const int kv = threadIdx.x >> 7, j = threadIdx.x & 127; float s = a.in[I_CB1][kv * 128 + j];
        for (int ks = 0; ks < 16; ++ks) s += ((const float*)(ws + WS_B1PP))[(kv * 16 + ks) * 128 + j];
        ((float*)(ws + WS_B1P))[kv * 256 + j] = s; ((float*)(ws + WS_B1P))[kv * 256 + 128 + j] = 0.f;
    }
    const int lane = threadIdx.x & 63, gw = blockIdx.x * 8 + (threadIdx.x >> 6), NGW = gridDim.x * 8;
    f32x4 v[2][4], vn[2][4];
#pragma unroll
    for (int u = 0; u < 2; ++u) { const int row = min(gw + u * NGW, MTOK - 1); const f32x4* xr = (const f32x4*)(a.in[I_X] + (size_t)row * DM) + lane;
#pragma unroll
        for (int j = 0; j < 4; ++j) v[u][j] = __builtin_nontemporal_load(xr + 64 * j); }
#pragma unroll 1
    for (int row0 = gw; row0 < MTOK; row0 += 2 * NGW) {
#pragma unroll
        for (int u = 0; u < 2; ++u) { const int row = min(row0 + (2 + u) * NGW, MTOK - 1); const f32x4* xr = (const f32x4*)(a.in[I_X] + (size_t)row * DM) + lane;
#pragma unroll
            for (int j = 0; j < 4; ++j) vn[u][j] = __builtin_nontemporal_load(xr + 64 * j); }
#pragma unroll
        for (int u = 0; u < 2; ++u) {
            const int row = row0 + u * NGW;
            if (row < MTOK) {
                const int b = row >> 11; float s = 0.f;
#pragma unroll
                for (int j = 0; j < 4; ++j) s += (v[u][j][0] * v[u][j][0] + v[u][j][1] * v[u][j][1]) + (v[u][j][2] * v[u][j][2] + v[u][j][3] * v[u][j][3]);
                const float rstd = 1.0f / sqrtf(wave_sum(s) * (1.f / DM) + EPS);
                u32x2* o = (u32x2*)((bf16_t*)(ws + WS_H) + (size_t)row * DM) + lane;
#pragma unroll
                for (int j = 0; j < 4; ++j) { const int c = 256 * j + 4 * lane;
                    const f32x4 g = *(const f32x4*)(a.in[I_GPM] + c), sh = *(const f32x4*)(mod + (size_t)b * 6144 + c), sc = *(const f32x4*)(mod + (size_t)b * 6144 + 1024 + c);
                    float h[4];
#pragma unroll
                    for (int e = 0; e < 4; ++e) h[e] = (v[u][j][e] * rstd * g[e]) * (1.f + sc[e]) + sh[e];
                    o[64 * j] = (u32x2){cvt_pk_bf16(h[0], h[1]), cvt_pk_bf16(h[2], h[3])}; }
            }
        }
#pragma unroll
        for (int u = 0; u < 2; ++u)
#pragma unroll
            for (int j = 0; j < 4; ++j) v[u][j] = vn[u][j];
    }
}

constexpr int SC_STRIDE = 2052;
__device__ __forceinline__ unsigned fkey(float f) { unsigned u = __float_as_uint(f); if (u == 0x80000000u) u = 0u; return (u >> 31) ? ~u : (u | 0x80000000u); }
__device__ __forceinline__ int count_ge8(unsigned k0, unsigned k1, unsigned k2, unsigned k3, unsigned k4, unsigned k5, unsigned k6, unsigned k7, unsigned c) {
    u64 m0, m1, m2, m3, m4, m5, m6, m7;
    asm("v_cmp_ge_u32_e64 %0, %8, %16\n\tv_cmp_ge_u32_e64 %1, %9, %16\n\tv_cmp_ge_u32_e64 %2, %10, %16\n\tv_cmp_ge_u32_e64 %3, %11, %16\n\t"
        "v_cmp_ge_u32_e64 %4, %12, %16\n\tv_cmp_ge_u32_e64 %5, %13, %16\n\tv_cmp_ge_u32_e64 %6, %14, %16\n\tv_cmp_ge_u32_e64 %7, %15, %16"
        : "=&s"(m0), "=&s"(m1), "=&s"(m2), "=&s"(m3), "=&s"(m4), "=&s"(m5), "=&s"(m6), "=&s"(m7)
        : "v"(k0), "v"(k1), "v"(k2), "v"(k3), "v"(k4), "v"(k5), "v"(k6), "v"(k7), "v"(c));
    return (__popcll(m0) + __popcll(m1)) + (__popcll(m2) + __popcll(m3)) + ((__popcll(m4) + __popcll(m5)) + (__popcll(m6) + __popcll(m7)));
}
__device__ __forceinline__ void idx_unit(const Args& a, LAS unsigned char* lds, int b, int tile) {
    unsigned char* ws = a.ws;
    const int tid = threadIdx.x, lane = tid & 63, wid = __builtin_amdgcn_readfirstlane(tid >> 6), t0 = tile * 16;
    LAS float* SC = (LAS float*)lds;
#ifndef MK_IDX_REP_SCORE
#define MK_IDX_REP_SCORE 1
#endif
#ifndef MK_IDX_REP_SEL
#define MK_IDX_REP_SEL 1
#endif
    const bool need_scores = (t0 + 15) >= 256;
#pragma unroll 1
    for (int rs_ = 0; rs_ < MK_IDX_REP_SCORE; ++rs_)
    if (need_scores) {
        const int tq = lane & 15, fq = lane >> 4;
        const size_t trow = (size_t)b * SEQ + t0 + tq;
        const bf16_t* Qi = (const bf16_t*)(ws + WS_QI) + trow * 512;
        bf16x8 qb[8][2]; float wv[8];
#pragma unroll
        for (int h = 0; h < 8; ++h) { qb[h][0] = *(const bf16x8*)(Qi + h * 64 + 8 * fq); qb[h][1] = *(const bf16x8*)(Qi + h * 64 + 32 + 8 * fq); }
        { const f32x4 w0 = *(const f32x4*)((const float*)(ws + WS_WI) + trow * 8), w1 = *(const f32x4*)((const float*)(ws + WS_WI) + trow * 8 + 4);
          wv[0] = w0[0]; wv[1] = w0[1]; wv[2] = w0[2]; wv[3] = w0[3]; wv[4] = w1[0]; wv[5] = w1[1]; wv[6] = w1[2]; wv[7] = w1[3]; }
        const bf16_t* Ki = (const bf16_t*)(ws + WS_KI) + (size_t)b * SEQ * 64 + (size_t)tq * 64 + 8 * fq;
        bf16x8 kf[4][2];
#pragma unroll
        for (int u = 0; u < 4; ++u) { const int cs = min(wid + 8 * u, tile); kf[u][0] = *(const bf16x8*)(Ki + (size_t)cs * 1024); kf[u][1] = *(const bf16x8*)(Ki + (size_t)cs * 1024 + 32); }
#pragma unroll 1
        for (int st = wid; st <= tile; st += 32) {
#pragma unroll
            for (int u = 0; u < 4; ++u) {
                const int cs = st + 8 * u;
                const bf16x8 k0 = kf[u][0], k1 = kf[u][1];
                f32x4 sc = {0.f, 0.f, 0.f, 0.f};
                if (cs <= tile) {
                    f32x4 d[8];
#pragma unroll
                    for (int h = 0; h < 8; ++h) {
                        d[h] = __builtin_amdgcn_mfma_f32_16x16x32_bf16(k0, qb[h][0], (f32x4){0.f, 0.f, 0.f, 0.f}, 0, 0, 0);
                        d[h] = __builtin_amdgcn_mfma_f32_16x16x32_bf16(k1, qb[h][1], d[h], 0, 0, 0);
                    }
                    asm volatile("s_nop 15\n\ts_nop 7" : "+v"(d[0]), "+v"(d[1]), "+v"(d[2]), "+v"(d[3]), "+v"(d[4]), "+v"(d[5]), "+v"(d[6]), "+v"(d[7]));
#pragma unroll
                    for (int h = 0; h < 8; ++h)
#pragma unroll
                        for (int j = 0; j < 4; ++j) sc[j] += wv[h] * relu1(d[h][j]);
                }
                { const int cn = min(cs + 32, tile); kf[u][0] = *(const bf16x8*)(Ki + (size_t)cn * 1024); kf[u][1] = *(const bf16x8*)(Ki + (size_t)cn * 1024 + 32); }
                if (cs <= tile) *(LAS u32x4*)(SC + tq * SC_STRIDE + cs * 16 + 4 * fq) = (u32x4){fkey(sc[0]), fkey(sc[1]), fkey(sc[2]), fkey(sc[3])};
            }
        }
    }
    __syncthreads();
#pragma unroll 1
    for (int rsel_ = 0; rsel_ < MK_IDX_REP_SEL; ++rsel_) {
    const LAS unsigned* KEY = (const LAS unsigned*)lds;
    const int ta = t0 + 2 * wid, tb = ta + 1;
    u64* moa = (u64*)(ws + WS_MASKD) + ((size_t)b * SEQ + ta) * 32;
    unsigned wlo_a = 0u, whi_a = 0u, wlo_b = 0u, whi_b = 0u;
#define IDX_PUT(WLO, WHI, i, w) do { const unsigned lo_ = (unsigned)(w), hi_ = (unsigned)((w) >> 32); \
        asm volatile("s_nop 1\n\tv_writelane_b32 %0, %2, %4\n\tv_writelane_b32 %1, %3, %4" : "+v"(WLO), "+v"(WHI) : "s"(lo_), "s"(hi_), "i"(i)); } while (0)
    if (tb < 256) {
#pragma unroll
        for (int i = 0; i < 32; ++i) { const u64 wa = __ballot(64 * i + lane <= ta), wb = __ballot(64 * i + lane <= tb); IDX_PUT(wlo_a, whi_a, i, wa); IDX_PUT(wlo_b, whi_b, i, wb); }
    } else {
        unsigned ka[32], kb[32];
        const int nreg = (tb >> 6) + 1;
#pragma unroll
        for (int i = 0; i < 32; ++i) { const int sidx = 64 * i + lane;
            if (i < nreg) { const unsigned va = KEY[(2 * wid) * SC_STRIDE + sidx], vb = KEY[(2 * wid + 1) * SC_STRIDE + sidx]; ka[i] = (sidx <= ta) ? va : 0u; kb[i] = (sidx <= tb) ? vb : 0u; }
            else { ka[i] = 0u; kb[i] = 0u; } }
        unsigned Ta = 0u, Tb = 0u; bool ea = false, eb = false;
#pragma unroll 1
        for (int bit = 31; bit >= 0; --bit) {
            if (!ea) {
                const unsigned c = Ta | (1u << bit); int cnt = 0;
#pragma unroll
                for (int i0 = 0; i0 < 32; i0 += 8) if (i0 < nreg) cnt += count_ge8(ka[i0], ka[i0 + 1], ka[i0 + 2], ka[i0 + 3], ka[i0 + 4], ka[i0 + 5], ka[i0 + 6], ka[i0 + 7], c);
                if (cnt >= 256) { Ta = c; ea = (cnt == 256); }
            }
            if (!eb) {
                const unsigned c = Tb | (1u << bit); int cnt = 0;
#pragma unroll
                for (int i0 = 0; i0 < 32; i0 += 8) if (i0 < nreg) cnt += count_ge8(kb[i0], kb[i0 + 1], kb[i0 + 2], kb[i0 + 3], kb[i0 + 4], kb[i0 + 5], kb[i0 + 6], kb[i0 + 7], c);
                if (cnt >= 256) { Tb = c; eb = (cnt == 256); }
            }
            if (ea && eb) break;
        }
#define IDX_FINISH(K, T, EX, WLO, WHI) do { \
            if (EX) { _Pragma("unroll") for (int i = 0; i < 32; ++i) { const u64 w_ = __ballot(K[i] >= T); IDX_PUT(WLO, WHI, i, w_); } } \
            else { int ngt_ = 0; _Pragma("unroll") for (int i = 0; i < 32; ++i) ngt_ += __popcll(__ballot(K[i] > T)); \
                int need_ = 256 - ngt_;                            \
                _Pragma("unroll") for (int i = 0; i < 32; ++i) { const bool gt_ = K[i] > T, eq_ = K[i] == T; const u64 em_ = __ballot(eq_); \
                    const int before_ = __popcll(em_ & ((1ull << lane) - 1ull)); const bool take_ = eq_ && (before_ < need_); const u64 w_ = __ballot(gt_ || take_); \
                    need_ -= __popcll(em_); if (need_ < 0) need_ = 0; IDX_PUT(WLO, WHI, i, w_); } } } while (0)
        IDX_FINISH(ka, Ta, ea, wlo_a, whi_a);
        IDX_FINISH(kb, Tb, eb, wlo_b, whi_b);
#undef IDX_FINISH
    }
#undef IDX_PUT
    if (lane < 32) { moa[lane] = ((u64)whi_a << 32) | wlo_a; moa[32 + lane] = ((u64)whi_b << 32) | wlo_b; }
    }
    __syncthreads();
}

constexpr int PS_STRIDE = 132;
constexpr int CMP_KC_OFF = 36864, CMP_KC_STR = 144, CMP_VT_OFF = CMP_KC_OFF + 128 * CMP_KC_STR, CMP_VT_STR = 264;
__device__ __forceinline__ void cmp_unit(const Args& a, LAS unsigned char* lds, int plane, int tt) {
    unsigned char* ws = a.ws;
    const int tid = threadIdx.x, lane = tid & 63, wid = __builtin_amdgcn_readfirstlane(tid >> 6), r32 = lane & 31, hi = lane >> 5;
    const int b = plane >> 1, g = plane & 1, t0 = tt * 64;
    const int tl = r32 >> 2, hd = r32 & 3, t = t0 + 8 * wid + tl;
    const size_t trow = (size_t)b * SEQ + t;
    const int nmax = (t0 + 32) >> 4, nbmax = nmax >> 5;
    const bf16_t* Qn = (const bf16_t*)(ws + WS_QN) + trow * 512 + (g * 4 + hd) * 64;
    bf16x8 qr[4];
#pragma unroll
    for (int d0 = 0; d0 < 4; ++d0) qr[d0] = *(const bf16x8*)(Qn + d0 * 16 + hi * 8);
    const LAS unsigned char* KC = lds + CMP_KC_OFF;
    f32x16 p[4];
    {
        bf16x8 kf[4][4];
#pragma unroll
        for (int nb = 0; nb < 4; ++nb)
#pragma unroll
            for (int d0 = 0; d0 < 4; ++d0) kf[nb][d0] = *(const LAS bf16x8*)(KC + (nb * 32 + r32) * CMP_KC_STR + (d0 * 16 + hi * 8) * 2);
#pragma unroll
        for (int nb = 0; nb < 4; ++nb) {
            p[nb] = (f32x16){0.f, 0.f, 0.f, 0.f, 0.f, 0.f, 0.f, 0.f, 0.f, 0.f, 0.f, 0.f, 0.f, 0.f, 0.f, 0.f};
            if (nb <= nbmax) {
#pragma unroll
                for (int d0 = 0; d0 < 4; ++d0) p[nb] = __builtin_amdgcn_mfma_f32_32x32x16_bf16(kf[nb][d0], qr[d0], p[nb], 0, 0, 0);
            }
        }
    }
    const LAS unsigned char* VT = lds + CMP_VT_OFF;
    u32x2 vlo[4][2][2], vhh[4][2][2];
#pragma unroll
    for (int nb = 0; nb < 4; ++nb)
#pragma unroll
        for (int ks = 0; ks < 2; ++ks)
#pragma unroll
            for (int d0 = 0; d0 < 2; ++d0) { const LAS unsigned char* vp = VT + (d0 * 32 + r32) * CMP_VT_STR + (nb * 32 + ks * 16 + 4 * hi) * 2; vlo[nb][ks][d0] = *(const LAS u32x2*)vp; vhh[nb][ks][d0] = *(const LAS u32x2*)(vp + 16); }
    const float* Gt = (const float*)(ws + WS_GT);
    float rm = NEGBIG;
#pragma unroll
    for (int nb = 0; nb < 4; ++nb)
#pragma unroll
        for (int r = 0; r < 16; ++r) { const int n = nb * 32 + crow(r, hi); const bool valid = (16 * n + 31) <= t; const float sv = valid ? p[nb][r] : NEGBIG; p[nb][r] = sv; rm = fmaxf(rm, sv); }
    rm = swap_max(rm);
    if (rm < -1e29f) rm = 1e30f;
    float ls = 0.f;
#pragma unroll
    for (int nb = 0; nb < 4; ++nb)
#pragma unroll
        for (int r = 0; r < 16; ++r) { const float e = fast_exp2(p[nb][r] - rm); p[nb][r] = e; ls += e; }
    ls = swap_sum(ls);
    const float inv = 1.0f / fmaxf(ls, 1e-30f);
    LAS float* PS = (LAS float*)lds + wid * 8 * PS_STRIDE;
#pragma unroll
    for (int nb = 0; nb < 4; ++nb)
#pragma unroll
        for (int rg = 0; rg < 4; ++rg) {
            f32x4 sm;
#pragma unroll
            for (int e = 0; e < 4; ++e) { const float pn = p[nb][4 * rg + e] * inv; p[nb][4 * rg + e] = pn;
                float x = pn + quad_xor1(pn); x += quad_xor2(x); sm[e] = x; }
            *(LAS f32x4*)(PS + tl * PS_STRIDE + nb * 32 + 8 * rg + 4 * hi) = sm;
        }
    asm volatile("s_waitcnt lgkmcnt(0)" ::: "memory");
    f32x16 o[2];
    o[0] = (f32x16){0.f, 0.f, 0.f, 0.f, 0.f, 0.f, 0.f, 0.f, 0.f, 0.f, 0.f, 0.f, 0.f, 0.f, 0.f, 0.f}; o[1] = o[0];
#pragma unroll
    for (int nb = 0; nb < 4; ++nb) {
        if (nb <= nbmax) {
#pragma unroll
            for (int ks = 0; ks < 2; ++ks) {
                u32x4 pw; pw.x = cvt_pk_bf16(p[nb][8 * ks + 0], p[nb][8 * ks + 1]); pw.y = cvt_pk_bf16(p[nb][8 * ks + 2], p[nb][8 * ks + 3]);
                pw.z = cvt_pk_bf16(p[nb][8 * ks + 4], p[nb][8 * ks + 5]); pw.w = cvt_pk_bf16(p[nb][8 * ks + 6], p[nb][8 * ks + 7]);
                asm volatile("s_nop 1" : "+v"(pw));
                const bf16x8 pa = __builtin_bit_cast(bf16x8, pw);
#pragma unroll
                for (int d0 = 0; d0 < 2; ++d0) {
                    const bf16x8 vb = __builtin_bit_cast(bf16x8, (u32x4){vlo[nb][ks][d0].x, vlo[nb][ks][d0].y, vhh[nb][ks][d0].x, vhh[nb][ks][d0].y});
                    o[d0] = __builtin_amdgcn_mfma_f32_32x32x16_bf16(pa, vb, o[d0], 0, 0, 0);
                }
            }
        }
    }
    bf16_t* OC = (bf16_t*)(ws + WS_OCMP);
#pragma unroll
    for (int r = 0; r < 16; ++r) { const int q = crow(r, hi); const size_t orow = (size_t)b * SEQ + t0 + 8 * wid + (q >> 2); const int head = g * 4 + (q & 3);
        const float g0 = Gt[orow * 24 + head];
#pragma unroll
        for (int d0 = 0; d0 < 2; ++d0) OC[orow * 512 + head * 64 + d0 * 32 + r32] = (bf16_t)(cvt_pk_bf16(o[d0][r] * g0, 0.f) & 0xffffu); }
    {
        const int tk = lane & 7, blk = tt;
        float val[32];
        float prev_last = 0.f;
#pragma unroll
        for (int j = 0; j < 32; ++j) { const f32x4 x = *(const LAS f32x4*)(PS + tk * PS_STRIDE + 4 * j);
            const float imp = ((x[0] + x[1]) + (x[2] + x[3])) + prev_last; prev_last = x[3];
            val[j] = (j >= 1 && j <= blk - 2) ? imp : -INFINITY; }
        unsigned sel = 1u | (1u << blk) | (blk >= 1 ? (1u << (blk - 1)) : 0u);
#pragma unroll 1
        for (int round = 0; round < 5; ++round) {
            float best = -INFINITY; int bi = -1;
#pragma unroll
            for (int j = 0; j < 32; ++j) if (val[j] > best) { best = val[j]; bi = j; }
            if (bi >= 0) sel |= 1u << bi;
#pragma unroll
            for (int j = 0; j < 32; ++j) val[j] = (j == bi) ? -INFINITY : val[j];
        }
        if (lane < 8) ((unsigned*)(ws + WS_BM))[(size_t)plane * SEQ + t0 + 8 * wid + lane] = sel;
    }
    __syncthreads();
}

namespace fa {
constexpr int VSTR = 144, KCH = 1040, KBUF = 8 * KCH, VBUF = 64 * VSTR, OFF_V = 4 * KBUF, OFF_SCR = OFF_V + 4 * VBUF, OFF_STAGE = OFF_SCR + 2048;
__device__ __forceinline__ float bfi_f(unsigned msk, float a, float b) { return __uint_as_float((__float_as_uint(a) & msk) | (__float_as_uint(b) & ~msk)); }
template <int H>
__device__ __forceinline__ void load_k_half(const LAS unsigned char* kbuf, int r32, int hi, bf16x8 (&kf)[8]) {
    const LAS unsigned char* kb = kbuf + hi * KCH + r32 * 16;
#pragma unroll
    for (int d0 = 2 * H; d0 < 2 * H + 2; ++d0) { kf[2 * d0] = *(const LAS bf16x8*)(kb + d0 * 2 * KCH); kf[2 * d0 + 1] = *(const LAS bf16x8*)(kb + d0 * 2 * KCH + 512); }
}
__device__ __forceinline__ void load_k(const LAS unsigned char* kbuf, int r32, int hi, bf16x8 (&kf)[8]) {
    const LAS unsigned char* kb = kbuf + hi * KCH + r32 * 16;
#pragma unroll
    for (int d0 = 0; d0 < 4; ++d0) { kf[2 * d0] = *(const LAS bf16x8*)(kb + d0 * 2 * KCH); kf[2 * d0 + 1] = *(const LAS bf16x8*)(kb + d0 * 2 * KCH + 512); }
}
__device__ __forceinline__ void mma_qk(const bf16x8 (&kf)[8], const bf16x8 (&qr)[4], const f32x16& negm, f32x16& p0, f32x16& p1) {
    p0 = __builtin_amdgcn_mfma_f32_32x32x16_bf16(kf[0], qr[0], negm, 0, 0, 0); p1 = __builtin_amdgcn_mfma_f32_32x32x16_bf16(kf[1], qr[0], negm, 0, 0, 0);
#pragma unroll
    for (int d0 = 1; d0 < 4; ++d0) { p0 = __builtin_amdgcn_mfma_f32_32x32x16_bf16(kf[2 * d0], qr[d0], p0, 0, 0, 0); p1 = __builtin_amdgcn_mfma_f32_32x32x16_bf16(kf[2 * d0 + 1], qr[d0], p1, 0, 0, 0); }
}
__device__ __forceinline__ void load_v(const LAS unsigned char* vbuf, int r32, int hi, bf16x8 (&vf)[8]) {
    const LAS unsigned char* vb = vbuf + r32 * VSTR + hi * 16;
#pragma unroll
    for (int ks = 0; ks < 4; ++ks) { vf[2 * ks] = *(const LAS bf16x8*)(vb + ks * 32); vf[2 * ks + 1] = *(const LAS bf16x8*)(vb + 32 * VSTR + ks * 32); }
}
__device__ __forceinline__ void mma_pv(const bf16x8 (&vf)[8], const u32x4 (&pw)[4], f32x16& o0, f32x16& o1) {
#pragma unroll
    for (int ks = 0; ks < 4; ++ks) {
        const bf16x8 pa = __builtin_bit_cast(bf16x8, pw[ks]);
        o0 = __builtin_amdgcn_mfma_f32_32x32x16_bf16(pa, vf[2 * ks], o0, 0, 0, 0);
        o1 = __builtin_amdgcn_mfma_f32_32x32x16_bf16(pa, vf[2 * ks + 1], o1, 0, 0, 0);
    }
}
__device__ __forceinline__ void qk_mfma(const LAS unsigned char* kbuf, const bf16x8 (&qr)[4], const f32x16& negm, int r32, int hi, f32x16& p0, f32x16& p1) {
    bf16x8 kf[8]; load_k(kbuf, r32, hi, kf); mma_qk(kf, qr, negm, p0, p1);
}
__device__ __forceinline__ void pv_mfma(const LAS unsigned char* vbuf, const u32x4 (&pw)[4], int r32, int hi, f32x16& o0, f32x16& o1) {
    bf16x8 vf[8]; load_v(vbuf, r32, hi, vf); mma_pv(vf, pw, o0, o1);
}
template <int MODE>
__device__ __forceinline__ void apply_mask(int j, int j1, int t, int tw0, bool selj, u64 mbits, bool chk, int hi, f32x16& p0, f32x16& p1) {
    const int kv0 = j * 64, d = t - kv0;
    u64 w = mbits; bool need = true;
    if (MODE == 0) {
        const u64 low = (d >= 63) ? ~0ull : ((2ull << d) - 1ull);
        w = selj ? low : 0ull;
        need = (j == j1);
    } else if (MODE == 1) {
        const u64 low = (d >= 63) ? ~0ull : ((2ull << d) - 1ull);
        const int e = d - 512;
        const u64 high = (e < 0) ? ~0ull : ((e >= 63) ? 0ull : ~((2ull << e) - 1ull));
        w = low & high;
        need = !((kv0 + 63 <= tw0) && (kv0 > tw0 + 31 - 512));
    }
    if (need) {
        w >>= (4 * hi);
        const unsigned wl = (unsigned)w, wh = (unsigned)(w >> 32);
#pragma unroll
        for (int r = 0; r < 16; ++r) { const int pos = (r & 3) + 8 * (r >> 2);
            p0[r] = bfi_f((unsigned)__builtin_amdgcn_sbfe((int)wl, pos, 1), p0[r], NEGBIG);
            p1[r] = bfi_f((unsigned)__builtin_amdgcn_sbfe((int)wh, pos, 1), p1[r], NEGBIG); }
    }
}
template <bool ASM>
__device__ __forceinline__ float row_max_rel(const f32x16& p0, const f32x16& p1) {
    if (ASM) {
        float ra = max3f(p0[0], p0[1], p1[0]), rb = max3f(p0[2], p0[3], p1[1]);
        ra = max3f(ra, p1[2], p1[3]);
#pragma unroll
        for (int r = 4; r < 16; r += 4) { ra = max3f(ra, p0[r], p0[r + 1]); rb = max3f(rb, p0[r + 2], p0[r + 3]); ra = max3f(ra, p1[r], p1[r + 1]); rb = max3f(rb, p1[r + 2], p1[r + 3]); }
        float rm = max3f(ra, rb, 0.f);
        { auto rr = __builtin_amdgcn_permlane32_swap(__float_as_uint(rm), __float_as_uint(rm), false, false); rm = max3f(__uint_as_float(rr[0]), __uint_as_float(rr[1]), rm); }
        return rm;
    } else {
#define MX3(a, b, c) __builtin_fmaxf(__builtin_fmaxf((a), (b)), (c))
        float ra = MX3(p0[0], p0[1], p1[0]), rb = MX3(p0[2], p0[3], p1[1]);
        ra = MX3(ra, p1[2], p1[3]);
#pragma unroll
        for (int r = 4; r < 16; r += 4) { ra = MX3(ra, p0[r], p0[r + 1]); rb = MX3(rb, p0[r + 2], p0[r + 3]); ra = MX3(ra, p1[r], p1[r + 1]); rb = MX3(rb, p1[r + 2], p1[r + 3]); }
        float rm = MX3(ra, rb, 0.f);
        { auto rr = __builtin_amdgcn_permlane32_swap(__float_as_uint(rm), __float_as_uint(rm), false, false); rm = MX3(__uint_as_float(rr[0]), __uint_as_float(rr[1]), rm); }
#undef MX3
        return rm;
    }
}
__device__ __forceinline__ void move_reference(LAS float* scr, int r32, int hi, float rm, float& m, f32x16& negm, float& l, f32x16& o0, f32x16& o1) {
    m += rm;
#pragma unroll
    for (int r = 0; r < 16; ++r) negm[r] = -m;
    const float alpha = fast_exp2(-rm);
    l *= alpha;
    if (hi == 0) scr[r32] = alpha;
    asm volatile("s_waitcnt lgkmcnt(0)" ::: "memory");
#pragma unroll
    for (int r = 0; r < 16; ++r) { const float ar = scr[crow(r, hi)]; o0[r] *= ar; o1[r] *= ar; }
}
template <bool ASM>
__device__ __forceinline__ void range_check(LAS float* scr, int r32, int hi, f32x16& p0, f32x16& p1, float& m, f32x16& negm, float& l, f32x16& o0, f32x16& o1) {
    const float rm = row_max_rel<ASM>(p0, p1);
    if (__any(rm > 8.f)) {
#pragma unroll
        for (int r = 0; r < 16; ++r) { p0[r] -= rm; p1[r] -= rm; }
        move_reference(scr, r32, hi, rm, m, negm, l, o0, o1);
    }
}
__device__ __forceinline__ void exp_sum_pack(f32x16& p0, f32x16& p1, bool zero, u32x4 (&pw)[4], float& ls) {
    float s0 = 0.f, s1 = 0.f;
#pragma unroll
    for (int r = 0; r < 16; ++r) { p0[r] = fast_exp2(p0[r]); p1[r] = fast_exp2(p1[r]); s0 += p0[r]; s1 += p1[r]; }
    pw[0] = (u32x4){cvtpk_s(p0[0], p0[1]), cvtpk_s(p0[2], p0[3]), cvtpk_s(p0[4], p0[5]), cvtpk_s(p0[6], p0[7])};
    pw[1] = (u32x4){cvtpk_s(p0[8], p0[9]), cvtpk_s(p0[10], p0[11]), cvtpk_s(p0[12], p0[13]), cvtpk_s(p0[14], p0[15])};
    pw[2] = (u32x4){cvtpk_s(p1[0], p1[1]), cvtpk_s(p1[2], p1[3]), cvtpk_s(p1[4], p1[5]), cvtpk_s(p1[6], p1[7])};
    pw[3] = (u32x4){cvtpk_s(p1[8], p1[9]), cvtpk_s(p1[10], p1[11]), cvtpk_s(p1[12], p1[13]), cvtpk_s(p1[14], p1[15])};
    ls = s0 + s1;
    if (zero) { ls = 0.f;
#pragma unroll
        for (int q = 0; q < 4; ++q) pw[q] = (u32x4){0u, 0u, 0u, 0u}; }
}
template <int MODE>
__device__ __forceinline__ void tile_compute(LAS unsigned char* lds, int cur, int j, int j1, bool chk, const bf16x8 (&qr)[4], int t, int tw0, int tile_lim, unsigned bm, u64 mbits,
                                             LAS float* scr, int r32, int hi, float& m, f32x16& negm, float& l, f32x16& o0, f32x16& o1) {
    bool selj = true;
    if (MODE == 0) selj = (bm >> j) & 1u;
    const bool active = (MODE == 2) ? (j <= tile_lim) : true;
    if (!active) return;
    f32x16 p0, p1; u32x4 pw[4]; float ls;
    qk_mfma(lds + cur * KBUF, qr, negm, r32, hi, p0, p1);
    apply_mask<MODE>(j, j1, t, tw0, selj, mbits, chk, hi, p0, p1);
    if (chk) range_check<MODE == 2>(scr, r32, hi, p0, p1, m, negm, l, o0, o1);
    exp_sum_pack(p0, p1, (MODE == 0) && (j != j1) && !selj, pw, ls);
    l += ls;
    pv_mfma(lds + OFF_V + cur * VBUF, pw, r32, hi, o0, o1);
}
template <int MODE, class MidS, class MidL>
__device__ __forceinline__ void tile_pair(LAS unsigned char* lds, int cur, int ja, int j1, bool chk, const bf16x8 (&qr)[4], int t, int tw0, unsigned bm, u64 mbA, u64 mbB,
                                          LAS float* scr, int r32, int hi, float& m, f32x16& negm, float& l, f32x16& o0, f32x16& o1, const MidS& mid_store, const MidL& mid_load) {
    bool selA = true, selB = true;
    if (MODE == 0) { selA = (bm >> ja) & 1u; selB = (bm >> (ja + 1)) & 1u; }
    f32x16 a0, a1, b0, b1; u32x4 pwA[4], pwB[4]; float lsA, lsB;
    bf16x8 kfA[8], kfB[8], vfA[8], vfB[8];
    load_k(lds + cur * KBUF, r32, hi, kfA);
    mma_qk(kfA, qr, negm, a0, a1);
    __builtin_amdgcn_sched_group_barrier(0x100, 8, 0); __builtin_amdgcn_sched_group_barrier(0x008, 8, 0);
    load_k_half<0>(lds + (cur + 1) * KBUF, r32, hi, kfB);
    mid_store();
    apply_mask<MODE>(ja, j1, t, tw0, selA, mbA, chk, hi, a0, a1);
    float rm = 0.f;
    if (chk) rm = row_max_rel<MODE == 2>(a0, a1);
    load_k_half<1>(lds + (cur + 1) * KBUF, r32, hi, kfB);
    mma_qk(kfB, qr, negm, b0, b1);
    exp_sum_pack(a0, a1, (MODE == 0) && (ja != j1) && !selA, pwA, lsA);
#pragma unroll
    for (int g = 0; g < 4; ++g) { __builtin_amdgcn_sched_group_barrier(0x008, 1, 0); __builtin_amdgcn_sched_group_barrier(0x100, 1, 0); __builtin_amdgcn_sched_group_barrier(0x002, 12, 0); }
#pragma unroll
    for (int g = 0; g < 4; ++g) { __builtin_amdgcn_sched_group_barrier(0x008, 1, 0); __builtin_amdgcn_sched_group_barrier(0x002, 12, 0); }
    l += lsA;
    __builtin_amdgcn_sched_barrier(0);
    mid_load();
    load_v(lds + OFF_V + cur * VBUF, r32, hi, vfA);
    apply_mask<MODE>(ja + 1, j1, t, tw0, selB, mbB, false, hi, b0, b1);
    mma_pv(vfA, pwA, o0, o1);
    exp_sum_pack(b0, b1, (MODE == 0) && (ja + 1 != j1) && !selB, pwB, lsB);
#pragma unroll
    for (int g = 0; g < 8; ++g) { __builtin_amdgcn_sched_group_barrier(0x008, 1, 0); __builtin_amdgcn_sched_group_barrier(0x002, 12, 0); }
    l += lsB;
    load_v(lds + OFF_V + (cur + 1) * VBUF, r32, hi, vfB);
    mma_pv(vfB, pwB, o0, o1);
    __builtin_amdgcn_sched_group_barrier(0x100, 8, 0); __builtin_amdgcn_sched_group_barrier(0x008, 8, 0);
    if (chk && __any(rm > 8.f)) move_reference(scr, r32, hi, rm, m, negm, l, o0, o1);
}
template <int MODE, bool PRE = false>
__device__ __forceinline__ void flash_pass(LAS unsigned char* lds, const bf16_t* Kb, const bf16_t* Vt, int kvstride, int j0, int j1,
                                           const bf16x8 (&qr)[4], int t, int tw0, int tile_lim, unsigned bm, const u64* mrow, float& m, float& l, f32x16& o0, f32x16& o1) {
    f32x16 negm = (f32x16){0.f, 0.f, 0.f, 0.f, 0.f, 0.f, 0.f, 0.f, 0.f, 0.f, 0.f, 0.f, 0.f, 0.f, 0.f, 0.f};
    int tid_ = threadIdx.x; asm volatile("" : "+v"(tid_));
    const int tid = tid_, lane = tid & 63, wid = __builtin_amdgcn_readfirstlane(tid >> 6), r32 = lane & 31, hi = lane >> 5;
    const int skv = tid >> 3, sc = tid & 7;
    LAS float* scr = (LAS float*)(lds + OFF_SCR) + wid * 64;
    const bf16_t* kp = Kb + (size_t)skv * kvstride + sc * 8;
    const bf16_t* vp = Vt + tid * 8;
    const size_t kts = (size_t)64 * kvstride;
    LAS unsigned char* kdst = lds + sc * KCH + skv * 16;
    LAS unsigned char* vdst = lds + OFF_V + skv * VSTR + (sc >> 1) * 32 + (sc & 1) * 8;
    u32x4 kA, vA, kB, vB; u64 mbA = 0ull, mbB = 0ull;
#define FA_LOAD(ja_) do { const int ja__ = min((ja_), j1), jb__ = min((ja_) + 1, j1); \
        kA = *(const u32x4*)(kp + (size_t)ja__ * kts); vA = *(const u32x4*)(vp + (size_t)ja__ * 4096); kB = *(const u32x4*)(kp + (size_t)jb__ * kts); vB = *(const u32x4*)(vp + (size_t)jb__ * 4096); } while (0)
#define FA_STORE(slot_) do { LAS unsigned char* kd_ = kdst + (slot_) * 2 * KBUF; LAS unsigned char* vd_ = vdst + (slot_) * 2 * VBUF; \
        *(LAS u32x4*)kd_ = kA; *(LAS u32x4*)(kd_ + KBUF) = kB; \
        *(LAS u32x2*)vd_ = (u32x2){vA.x, vA.y}; *(LAS u32x2*)(vd_ + 16) = (u32x2){vA.z, vA.w}; *(LAS u32x2*)(vd_ + VBUF) = (u32x2){vB.x, vB.y}; *(LAS u32x2*)(vd_ + VBUF + 16) = (u32x2){vB.z, vB.w}; } while (0)
    FA_LOAD(j0);
    if (MODE == 2) { mbA = mrow[j0]; mbB = mrow[min(j0 + 1, j1)]; }
    __syncthreads();
    FA_STORE(0);
    FA_LOAD(j0 + 2);
    __syncthreads();
    const int nt = j1 - j0 + 1;
    const int nfull = (MODE == 2) ? min((tile_lim - j0 + 1) >> 1, nt >> 1) : (nt >> 1);
    int ja = j0, slot = 0, step = 0;
#pragma unroll 1
    for (; step < nfull; ++step, ja += 2, slot ^= 1) {
        const u64 mcA = mbA, mcB = mbB;
        if (MODE == 2) { mbA = mrow[min(ja + 2, j1)]; mbB = mrow[min(ja + 3, j1)]; }
        tile_pair<MODE>(lds, 2 * slot, ja, j1, (step & 1) == 0, qr, t, tw0, bm, mcA, mcB, scr, r32, hi, m, negm, l, o0, o1,
                        [&]() { if (ja + 2 <= j1) FA_STORE(slot ^ 1); }, [&]() { FA_LOAD(ja + 4); });
        __syncthreads();
    }
#pragma unroll 1
    for (; ja <= j1; ++step, ja += 2, slot ^= 1) {
        const u64 mcA = mbA, mcB = mbB;
        if (MODE == 2) { mbA = mrow[min(ja + 2, j1)]; mbB = mrow[min(ja + 3, j1)]; }
        if (ja + 2 <= j1) FA_STORE(slot ^ 1);
        FA_LOAD(ja + 4);
        tile_compute<MODE>(lds, 2 * slot, ja, j1, (step & 1) == 0, qr, t, tw0, tile_lim, bm, mcA, scr, r32, hi, m, negm, l, o0, o1);
        if (ja + 1 <= j1) tile_compute<MODE>(lds, 2 * slot + 1, ja + 1, j1, false, qr, t, tw0, tile_lim, bm, mcB, scr, r32, hi, m, negm, l, o0, o1);
        __syncthreads();
    }
#undef FA_LOAD
#undef FA_STORE
}
__device__ __forceinline__ void row_factors(LAS unsigned char* lds, float f, float (&fr)[16]) {
    const int lane = threadIdx.x & 63, wid = __builtin_amdgcn_readfirstlane(threadIdx.x >> 6), r32 = lane & 31, hi = lane >> 5;
    LAS float* scr = (LAS float*)(lds + OFF_SCR) + wid * 64 + 32;
    if (hi == 0) scr[r32] = f;
    asm volatile("s_waitcnt lgkmcnt(0)" ::: "memory");
#pragma unroll
    for (int r = 0; r < 16; ++r) fr[r] = scr[crow(r, hi)];
    asm volatile("s_waitcnt lgkmcnt(0)" ::: "memory");
}
__device__ __forceinline__ void nsa_unit(const Args& a, LAS unsigned char* lds, int plane, int blk) {
    unsigned char* ws = a.ws;
    const int tid = threadIdx.x, lane = tid & 63, wid = __builtin_amdgcn_readfirstlane(tid >> 6), r32 = lane & 31, hi = lane >> 5;
    const int b = plane >> 1, g = plane & 1, t0 = blk * 64, hd = wid & 3, head = g * 4 + hd;
    const int tw0 = t0 + 32 * (wid >> 2), t = tw0 + r32;
    const size_t trow = (size_t)b * SEQ + t;
    const bf16_t* Qn = (const bf16_t*)(ws + WS_QN) + trow * 512 + head * 64;
    bf16x8 qr[4];
#pragma unroll
    for (int d0 = 0; d0 < 4; ++d0) qr[d0] = *(const bf16x8*)(Qn + d0 * 16 + hi * 8);
    const unsigned bm = ((const unsigned*)(ws + WS_BM))[(size_t)plane * SEQ + t];
    const float* Gt = (const float*)(ws + WS_GT) + trow * 24;
    const float g1 = Gt[8 + head], g2 = Gt[16 + head];
    const size_t pbase = (size_t)plane * SEQ * 64;
    const f32x16 z = (f32x16){0.f, 0.f, 0.f, 0.f, 0.f, 0.f, 0.f, 0.f, 0.f, 0.f, 0.f, 0.f, 0.f, 0.f, 0.f, 0.f};
    LAS float* stage = (LAS float*)(lds + OFF_STAGE) + wid * 2048 + lane;
    f32x16 res0, res1;
    {
        float m = 0.f, l = 0.f; f32x16 o0 = z, o1 = z;
        flash_pass<0>(lds, (const bf16_t*)(ws + WS_KCR + 2 * PLANE_BUF) + pbase, (const bf16_t*)(ws + WS_KCR + 3 * PLANE_BUF) + pbase, 64, 0, blk, qr, t, tw0, 0, bm, nullptr, m, l, o0, o1);
        const float f = g1 / swap_sum(l); float fr[16]; row_factors(lds, f, fr);
#pragma unroll
        for (int r = 0; r < 16; ++r) { stage[(2 * r) * 64] = o0[r] * fr[r]; stage[(2 * r + 1) * 64] = o1[r] * fr[r]; }
    }
    {
        float m = 0.f, l = 0.f; f32x16 o0 = z, o1 = z;
        const int j0 = blk >= 8 ? blk - 8 : 0;
        flash_pass<1>(lds, (const bf16_t*)(ws + WS_KCR + 4 * PLANE_BUF) + pbase, (const bf16_t*)(ws + WS_KCR + 5 * PLANE_BUF) + pbase, 64, j0, blk, qr, t, tw0, 0, 0u, nullptr, m, l, o0, o1);
        const float f = g2 / swap_sum(l); float fr[16]; row_factors(lds, f, fr);
#pragma unroll
        for (int r = 0; r < 16; ++r) { res0[r] = o0[r] * fr[r] + stage[(2 * r) * 64]; res1[r] = o1[r] * fr[r] + stage[(2 * r + 1) * 64]; }
    }
    const bf16_t* OC = (const bf16_t*)(ws + WS_OCMP);
    bf16_t* AO = (bf16_t*)(ws + WS_AO);
    int hio = hi, r32o = r32; asm volatile("" : "+v"(hio), "+v"(r32o));
#pragma unroll
    for (int r = 0; r < 16; ++r) { const size_t orow = (size_t)b * SEQ + t0 + 32 * (wid >> 2) + crow(r, hio);
        const float c0 = bf2f(OC[orow * 512 + head * 64 + r32o]), c1 = bf2f(OC[orow * 512 + head * 64 + 32 + r32o]);
        AO[orow * DM + head * 64 + r32o] = (bf16_t)(cvt_pk_bf16(res0[r] + c0, 0.f) & 0xffffu);
        AO[orow * DM + head * 64 + 32 + r32o] = (bf16_t)(cvt_pk_bf16(res1[r] + c1, 0.f) & 0xffffu); }
}
__device__ __forceinline__ void dsa_unit(const Args& a, LAS unsigned char* lds, int b, int h, int qb) {
    unsigned char* ws = a.ws;
    int tid_ = threadIdx.x; asm volatile("" : "+v"(tid_));
    const int tid = tid_, lane = tid & 63, wid = __builtin_amdgcn_readfirstlane(tid >> 6), r32 = lane & 31, hi = lane >> 5;
    const int t0 = qb * 256, t = t0 + 32 * wid + r32;
    const size_t trow = (size_t)b * SEQ + t;
    const bf16_t* Qd = (const bf16_t*)(ws + WS_QD) + trow * 512 + h * 64;
    bf16x8 qr[4];
#pragma unroll
    for (int d0 = 0; d0 < 4; ++d0) qr[d0] = *(const bf16x8*)(Qd + d0 * 16 + hi * 8);
    const u64* mrow = (const u64*)(ws + WS_MASKD) + trow * 32;
    const f32x16 z = (f32x16){0.f, 0.f, 0.f, 0.f, 0.f, 0.f, 0.f, 0.f, 0.f, 0.f, 0.f, 0.f, 0.f, 0.f, 0.f, 0.f};
    float m = 0.f, l = 0.f; f32x16 o0 = z, o1 = z;
    const size_t kbase = (size_t)b * SEQ * 512 + h * 64;
    flash_pass<2>(lds, (const bf16_t*)(ws + WS_KD) + kbase, (const bf16_t*)(ws + WS_VD) + (size_t)(b * 8 + h) * 32 * 4096, 512, 0, 4 * qb + 3, qr, t, t0 + 32 * wid, 4 * qb + (wid >> 1), 0u, mrow, m, l, o0, o1);
    const float f = 1.0f / swap_sum(l); float fr[16]; row_factors(lds, f, fr);
    bf16_t* AO = (bf16_t*)(ws + WS_AO);
    int hio = hi, r32o = r32; asm volatile("" : "+v"(hio), "+v"(r32o));
#pragma unroll
    for (int r = 0; r < 16; ++r) { const size_t orow = (size_t)b * SEQ + t0 + 32 * wid + crow(r, hio);
        AO[orow * DM + 512 + h * 64 + r32o] = (bf16_t)(cvt_pk_bf16(o0[r] * fr[r], 0.f) & 0xffffu);
        AO[orow * DM + 512 + h * 64 + 32 + r32o] = (bf16_t)(cvt_pk_bf16(o1[r] * fr[r], 0.f) & 0xffffu); }
}
}

__device__ __forceinline__ void p7_mid(const Args& a) {
    unsigned char* ws = a.ws; const float* mod = (const float*)(ws + WS_MOD);
    const int lane = threadIdx.x & 63, gw = blockIdx.x * 8 + (threadIdx.x >> 6), NGW = gridDim.x * 8;
    f32x4 xv[2][4], xn[2][4]; u32x2 yv[2][4], yn[2][4]; float sv[2], sn[2];
#define P7_LOAD(X, Y, S, row) do { const f32x4* xr_ = (const f32x4*)(a.in[I_X] + (size_t)(row) * DM) + lane; const u32x2* yr_ = (const u32x2*)((const bf16_t*)(ws + WS_Y) + (size_t)(row) * DM) + lane; \
        _Pragma("unroll") for (int j = 0; j < 4; ++j) { X[j] = __builtin_nontemporal_load(xr_ + 64 * j); Y[j] = yr_[64 * j]; } S = (lane < 32) ? ((const float*)(ws + WS_SSQY))[(size_t)(row) * 32 + lane] : 0.f; } while (0)
#pragma unroll
    for (int u = 0; u < 2; ++u) { const int row = min(gw + u * NGW, MTOK - 1); P7_LOAD(xv[u], yv[u], sv[u], row); }
#pragma unroll 1
    for (int row0 = gw; row0 < MTOK; row0 += 2 * NGW) {
#pragma unroll
        for (int u = 0; u < 2; ++u) { const int row = min(row0 + (2 + u) * NGW, MTOK - 1); P7_LOAD(xn[u], yn[u], sn[u], row); }
#pragma unroll
        for (int u = 0; u < 2; ++u) {
            const int row = row0 + u * NGW;
            if (row < MTOK) {
                const int b = row >> 11;
                const float rstd_y = 1.0f / sqrtf(wave_sum(sv[u]) * (1.f / DM) + EPS);
                f32x4 x1[4]; float s2 = 0.f;
#pragma unroll
                for (int j = 0; j < 4; ++j) { const int c = 256 * j + 4 * lane;
                    const f32x4 gq = *(const f32x4*)(a.in[I_GQM] + c), ga = *(const f32x4*)(mod + (size_t)b * 6144 + 2048 + c);
                    const float yf[4] = {bflo(yv[u][j].x), bfhi(yv[u][j].x), bflo(yv[u][j].y), bfhi(yv[u][j].y)};
#pragma unroll
                    for (int e = 0; e < 4; ++e) { x1[j][e] = xv[u][j][e] + ga[e] * (yf[e] * rstd_y * gq[e]); s2 += x1[j][e] * x1[j][e]; }
                    }
                const float rstd = 1.0f / sqrtf(wave_sum(s2) * (1.f / DM) + EPS);
                u32x2* o = (u32x2*)((bf16_t*)(ws + WS_H) + (size_t)row * DM) + lane;
#pragma unroll
                for (int j = 0; j < 4; ++j) { const int c = 256 * j + 4 * lane;
                    const f32x4 g = *(const f32x4*)(a.in[I_GPF] + c), sh = *(const f32x4*)(mod + (size_t)b * 6144 + 3072 + c), sc = *(const f32x4*)(mod + (size_t)b * 6144 + 4096 + c);
                    float h[4];
#pragma unroll
                    for (int e = 0; e < 4; ++e) h[e] = (x1[j][e] * rstd * g[e]) * (1.f + sc[e]) + sh[e];
                    o[64 * j] = (u32x2){cvt_pk_bf16(h[0], h[1]), cvt_pk_bf16(h[2], h[3])}; }
            }
        }
#pragma unroll
        for (int u = 0; u < 2; ++u) { sv[u] = sn[u];
#pragma unroll
            for (int j = 0; j < 4; ++j) { xv[u][j] = xn[u][j]; yv[u][j] = yn[u][j]; } }
    }
#undef P7_LOAD
}
__device__ __forceinline__ void p10_final(const Args& a) {
    unsigned char* ws = a.ws; const float* mod = (const float*)(ws + WS_MOD);
    const int lane = threadIdx.x & 63, gw = blockIdx.x * 8 + (threadIdx.x >> 6), NGW = gridDim.x * 8;
    f32x4 xv[2][4], xn[2][4]; u32x2 yv[2][4], yn[2][4], zv[2][4], zn[2][4]; float sy[2], syn[2], sz[2], szn[2];
#define P10_LOAD(X, Y, Z, SY, SZ, row) do { const f32x4* xr_ = (const f32x4*)(a.in[I_X] + (size_t)(row) * DM) + lane; const u32x2* yr_ = (const u32x2*)((const bf16_t*)(ws + WS_Y) + (size_t)(row) * DM) + lane; \
        const u32x2* zr_ = (const u32x2*)((const bf16_t*)(ws + WS_Z) + (size_t)(row) * DM) + lane; \
        _Pragma("unroll") for (int j = 0; j < 4; ++j) { X[j] = __builtin_nontemporal_load(xr_ + 64 * j); Y[j] = yr_[64 * j]; Z[j] = zr_[64 * j]; } \
        SY = (lane < 32) ? ((const float*)(ws + WS_SSQY))[(size_t)(row) * 32 + lane] : 0.f; SZ = (lane < 32) ? ((const float*)(ws + WS_SSQZ))[(size_t)(row) * 32 + lane] : 0.f; } while (0)
#pragma unroll
    for (int u = 0; u < 2; ++u) { const int row = min(gw + u * NGW, MTOK - 1); P10_LOAD(xv[u], yv[u], zv[u], sy[u], sz[u], row); }
#pragma unroll 1
    for (int row0 = gw; row0 < MTOK; row0 += 2 * NGW) {
#pragma unroll
        for (int u = 0; u < 2; ++u) { const int row = min(row0 + (2 + u) * NGW, MTOK - 1); P10_LOAD(xn[u], yn[u], zn[u], syn[u], szn[u], row); }
#pragma unroll
        for (int u = 0; u < 2; ++u) {
            const int row = row0 + u * NGW;
            if (row < MTOK) {
                const int b = row >> 11;
                const float rstd_y = 1.0f / sqrtf(wave_sum(sy[u]) * (1.f / DM) + EPS);
                const float rstd_z = 1.0f / sqrtf(wave_sum(sz[u]) * (1.f / DM) + EPS);
                f32x4* orow = (f32x4*)(a.out + (size_t)row * DM) + lane;
#pragma unroll
                for (int j = 0; j < 4; ++j) { const int c = 256 * j + 4 * lane;
                    const f32x4 gq = *(const f32x4*)(a.in[I_GQM] + c), ga = *(const f32x4*)(mod + (size_t)b * 6144 + 2048 + c);
                    const f32x4 gqf = *(const f32x4*)(a.in[I_GQF] + c), gaf = *(const f32x4*)(mod + (size_t)b * 6144 + 5120 + c);
                    const float yf[4] = {bflo(yv[u][j].x), bfhi(yv[u][j].x), bflo(yv[u][j].y), bfhi(yv[u][j].y)};
                    const float zf[4] = {bflo(zv[u][j].x), bfhi(zv[u][j].x), bflo(zv[u][j].y), bfhi(zv[u][j].y)};
                    f32x4 xo;
#pragma unroll
                    for (int e = 0; e < 4; ++e) { const float x1 = xv[u][j][e] + ga[e] * (yf[e] * rstd_y * gq[e]); xo[e] = x1 + gaf[e] * (zf[e] * rstd_z * gqf[e]); }
                    orow[64 * j] = xo; }
            }
        }
#pragma unroll
        for (int u = 0; u < 2; ++u) { sy[u] = syn[u]; sz[u] = szn[u];
#pragma unroll
            for (int j = 0; j < 4; ++j) { xv[u][j] = xn[u][j]; yv[u][j] = yn[u][j]; zv[u][j] = zn[u][j]; } }
    }
#undef P10_LOAD
}

__device__ __forceinline__ int queue_next(unsigned* head, volatile LAS unsigned* slot) {
    if (threadIdx.x == 0) *slot = __hip_atomic_fetch_add(head, 1u, __ATOMIC_RELAXED, __HIP_MEMORY_SCOPE_AGENT);
    __syncthreads();
    const int u = (int)*slot;
    __syncthreads();
    return u;
}

#ifndef MK_NVGPR
#define MK_NVGPR 256
#endif
__global__ void __launch_bounds__(512, 2) __attribute__((amdgpu_num_vgpr(MK_NVGPR))) mk_fwd(Args args) {
    extern __shared__ __attribute__((aligned(16))) unsigned char lds_raw[];
    LAS unsigned char* lds = (LAS unsigned char*)lds_raw;
    volatile LAS unsigned* MISC = (volatile LAS unsigned*)(lds + MISC_OFF);
    const int tid = threadIdx.x, G = gridDim.x, blk = blockIdx.x;
    unsigned char* ws = args.ws;
    unsigned* ctl = (unsigned*)(ws + WS_CTL);
    if (tid < 64) MISC[tid] = 0u;
    __syncthreads();
    XcdBarrier bar; bar.bar = ctl + CW_BAR + args.li * XCD_BAR_WORDS; bar.x = 0; bar.st = nullptr;
    if (MK_N_LAUNCHES != NPH) bar = xcd_barrier_post(ctl + CW_BAR + args.li * XCD_BAR_WORDS, MISC + 8);
    const int lo = args.ph_lo, hi = args.ph_hi;
#ifndef MK_PHASE_MASK
#define MK_PHASE_MASK 0xffffu
#endif
#ifndef MK_REPEAT_MASK
#define MK_REPEAT_MASK 0u
#endif
#define REP(k) for (int rep_ = 0; rep_ < (((MK_REPEAT_MASK >> (k)) & 1u) ? 2 : 1); ++rep_)
#define IN(k) ((MK_PHASE_MASK >> (k)) & 1u) && (lo <= (k) && (k) < hi)
#define SEAM(k) do { if (IN(k) && IN((k) + 1)) xcd_barrier(bar); } while (0)

    if (IN(0)) { REP(0) p0_prologue(args, lds); } SEAM(0);
    if (IN(1)) { REP(1) p1_hnorm(args); } SEAM(1);
    if (IN(2)) REP(2) {
        pg8::Gemm g{(const bf16_t*)(ws + WS_H), (const bf16_t*)(ws + WS_WIN), MTOK, NPROJ, DM, DM}; pg8::StaticOrder S; S.init(MTOK, NPROJ, G, blk);
        pg8::EpiInProj E{ws};
        pg8::gemm_phase<pg8::EpiInProj, pg8::StaticOrder, true>(lds, g, S, E);
    } SEAM(2);
    if (IN(3)) {
#ifndef MK_P3
#define MK_P3 7
#endif
        REP(11) {
        if ((MK_P3 & 1) && blk < 32) {
            const int kv = blk >> 4, pm = blk & 15;
            { pg8::Gemm g{(const bf16_t*)(ws + WS_KCR + (size_t)kv * PLANE_BUF), (const bf16_t*)(ws + WS_WC1) + (size_t)kv * 256 * 2048, 4096, 256, 2048, 1024};
              pg8::OneUnit S{pm, true}; pg8::EpiHid E{(bf16_t*)(ws + WS_HID) + (size_t)kv * 4096 * 256, (const float*)(ws + WS_B1P) + kv * 256};
              pg8::gemm_phase<pg8::EpiHid, pg8::OneUnit, false>(lds, g, S, E); }
            __builtin_amdgcn_fence(__ATOMIC_ACQUIRE, "agent"); asm volatile("s_waitcnt vmcnt(0)" ::: "memory"); __syncthreads();
            { pg8::Gemm g{(const bf16_t*)(ws + WS_HID) + (size_t)kv * 4096 * 256, (const bf16_t*)(ws + WS_WC2) + (size_t)kv * 256 * 256, 4096, 256, 256, 256};
              pg8::OneUnit S{pm, true}; pg8::EpiCmp E{ws, args.in[I_CB2] + kv * 64, kv};
              pg8::gemm_phase<pg8::EpiCmp, pg8::OneUnit, false>(lds, g, S, E); }
        }
        if (MK_P3 & 2) { pg8::Gemm g{(const bf16_t*)(ws + WS_CRAW), (const bf16_t*)(ws + WS_WKV), MTOK, 1024, 256, 256}; pg8::StaticOrder S; S.init(MTOK, 1024, G, blk);
          pg8::EpiKvGen E{ws};
          pg8::gemm_phase<pg8::EpiKvGen, pg8::StaticOrder, true>(lds, g, S, E); }
        }
        if (MK_P3 & 4) REP(3) for (;;) { const int u = queue_next(ctl + CW_Q_IDX + 256 * rep_, MISC + 4); if (u >= 2048) break; idx_unit(args, lds, u & 15, 127 - (u >> 4)); }
    } SEAM(3);
    if (IN(4)) {
        REP(4) {
            int cur_plane = -1;
            for (int u = blk; u < 1024; u += G) {
                const int plane = u & 31;
                if (plane != cur_plane) {
                    cur_plane = plane;
                    const bf16_t* KCg = (const bf16_t*)(ws + WS_KC) + (size_t)plane * 128 * 64;
                    const bf16_t* VTg = (const bf16_t*)(ws + WS_VCT) + (size_t)plane * 64 * 128;
                    __syncthreads();
                    for (int c = tid; c < 1024; c += 512) { const int n = c >> 3, ch = c & 7; *(LAS u32x4*)(lds + CMP_KC_OFF + n * CMP_KC_STR + ch * 16) = *(const u32x4*)(KCg + n * 64 + ch * 8); }
                    for (int c = tid; c < 1024; c += 512) { const int dd = c >> 4, ch = c & 15; const u32x4 v = *(const u32x4*)(VTg + dd * 128 + ch * 8);
                        LAS unsigned char* q = lds + CMP_VT_OFF + dd * CMP_VT_STR + ch * 16; *(LAS u32x2*)q = (u32x2){v.x, v.y}; *(LAS u32x2*)(q + 8) = (u32x2){v.z, v.w}; }
                    __syncthreads();
                }
                cmp_unit(args, lds, plane, u >> 5);
            }
        }
    } SEAM(4);
    if (IN(5)) {
        if (threadIdx.x >= 256) __builtin_amdgcn_s_setprio(1);
        REP(5) for (;;) { const int u = queue_next(ctl + CW_Q_FLASH + 256 * rep_, MISC + 4); if (u >= 2048) break;
            const int qb = 7 - (u >> 8), v = u & 255;
            if (v >= 32 && v < 160) { const int w = v - 32; fa::dsa_unit(args, lds, w >> 3, w & 7, qb); }
            else { const int s4 = (v < 32) ? 0 : ((v - 128) >> 5);
                   fa::nsa_unit(args, lds, v & 31, 4 * qb + 3 - s4); }
        }
        __builtin_amdgcn_s_setprio(0);
    } SEAM(5);
    if (IN(6)) REP(6) {
        pg8::Gemm g{(const bf16_t*)(ws + WS_AO), (const bf16_t*)(ws + WS_WOUT), MTOK, DM, DM, DM}; pg8::StaticOrder S; S.init(MTOK, DM, G, blk);
        pg8::EpiY E{(bf16_t*)(ws + WS_Y), (float*)(ws + WS_SSQY)};
        pg8::gemm_phase<pg8::EpiY, pg8::StaticOrder, true>(lds, g, S, E);
    } SEAM(6);
    if (IN(7)) { REP(7) p7_mid(args); } SEAM(7);
    if (IN(8)) REP(8) {
        pg8::Gemm g{(const bf16_t*)(ws + WS_H), (const bf16_t*)(ws + WS_WGU), MTOK, NGU, DM, DM}; pg8::StaticOrder S; S.init(MTOK, NGU, G, blk);
        pg8::EpiSwiglu E{(bf16_t*)(ws + WS_ACT)};
        pg8::gemm_phase<pg8::EpiSwiglu, pg8::StaticOrder, true>(lds, g, S, E);
    } SEAM(8);
    if (IN(9)) REP(9) {
        pg8::Gemm g{(const bf16_t*)(ws + WS_ACT), (const bf16_t*)(ws + WS_WDN), MTOK, DM, DFF, DFF}; pg8::StaticOrder S; S.init(MTOK, DM, G, blk);
        pg8::EpiY E{(bf16_t*)(ws + WS_Z), (float*)(ws + WS_SSQZ)};
        pg8::gemm_phase<pg8::EpiY, pg8::StaticOrder, true>(lds, g, S, E);
    } SEAM(9);
    if (IN(10)) { p10_final(args); }
#undef IN
#undef SEAM
}

extern "C" void kernel_launch(void* const* d_in, const int* in_sizes, int n_in, void* d_out, int out_size, void* d_ws, size_t ws_size, hipStream_t stream) {
    static int grid = 0;
    if (grid == 0) {
        if (n_in != 20 || in_sizes[0] != MTOK * DM || out_size != MTOK * DM || ws_size < WS_END) {
            fprintf(stderr, "kernel_launch: unexpected shapes (n_in %d, in0 %d, out %d, ws %zu; need ws >= %zu); nothing launched\n", n_in, n_in > 0 ? in_sizes[0] : -1, out_size, ws_size, (size_t)WS_END); grid = -1; return; }
        int dev = 0, cus = 0, per_cu = 0;
        if (hipGetDevice(&dev) != hipSuccess || hipDeviceGetAttribute(&cus, hipDeviceAttributeMultiprocessorCount, dev) != hipSuccess) { fprintf(stderr, "kernel_launch: device query failed\n"); grid = -1; return; }
        if (hipFuncSetAttribute((const void*)mk_fwd, hipFuncAttributeMaxDynamicSharedMemorySize, LDS_BYTES) != hipSuccess) { fprintf(stderr, "kernel_launch: hipFuncSetAttribute failed\n"); grid = -1; return; }
        if (hipOccupancyMaxActiveBlocksPerMultiprocessor(&per_cu, (const void*)mk_fwd, 512, LDS_BYTES) != hipSuccess || per_cu < 1)
            fprintf(stderr, "kernel_launch: note: occupancy query reports %d workgroups per CU\n", per_cu);
        (void)hipGetLastError();
        grid = cus;
    }
    if (grid < 0) return;
    if (hipMemsetAsync((char*)d_ws + WS_CTL, 0, CTL_ZERO_BYTES, stream) != hipSuccess) { fprintf(stderr, "kernel_launch: memset failed\n"); return; }
    Args a{};
    for (int i = 0; i < 20; ++i) a.in[i] = (const float*)d_in[i];
    a.out = (float*)d_out; a.ws = (unsigned char*)d_ws; a.pad = 0;
#if MK_N_LAUNCHES == 1
    a.ph_lo = 0; a.ph_hi = NPH; a.li = 0;
    hipLaunchKernelGGL(mk_fwd, dim3(grid), dim3(512), LDS_BYTES, stream, a);
#else
#ifndef MK_HOST_REP
#define MK_HOST_REP -1
#endif
    for (int li = 0; li < NPH; ++li) { a.ph_lo = li; a.ph_hi = li + 1; a.li = 0; hipLaunchKernelGGL(mk_fwd, dim3(grid), dim3(512), LDS_BYTES, stream, a);
        if (li == MK_HOST_REP) hipLaunchKernelGGL(mk_fwd, dim3(grid), dim3(512), LDS_BYTES, stream, a); }
#endif
    const hipError_t le = hipPeekAtLastError();
    if (le != hipSuccess) fprintf(stderr, "kernel_launch: launch failed: %s\n", hipGetErrorName(le));
}
```

```cpp
#include <hip/hip_runtime.h>
#include <cstdio>
#include <cstdint>

#define LAS __attribute__((address_space(3)))
#define GAS __attribute__((address_space(1)))
typedef unsigned short bf16_t;
typedef short bf16x8 __attribute__((ext_vector_type(8)));
typedef short s16x4 __attribute__((ext_vector_type(4)));
typedef float f32x2 __attribute__((ext_vector_type(2)));
typedef float f32x4 __attribute__((ext_vector_type(4)));
typedef float f32x16 __attribute__((ext_vector_type(16)));
typedef unsigned u32x2 __attribute__((ext_vector_type(2)));
typedef unsigned u32x4 __attribute__((ext_vector_type(4)));
typedef unsigned long long u64;

#ifndef MK_N_LAUNCHES
#define MK_N_LAUNCHES 1
#endif

constexpr int NB = 16, SEQ = 2048, DM = 1024, MTOK = NB * SEQ;
constexpr int NPROJ = 2560, DFF = 2816, NGU = 2 * DFF;
constexpr float EPS = 1e-6f;
constexpr float C2 = 0.125f * 1.4426950408889634f;
constexpr float NEGBIG = -1e30f;
constexpr int NPH = 11;

constexpr size_t MiB = 1u << 20;
constexpr size_t WS_CTL = 0, CTL_ZERO_BYTES = 1 * MiB;
constexpr size_t WS_ROPE = 1 * MiB;
constexpr size_t WS_MOD = WS_ROPE + 128 * 1024;
constexpr size_t WS_B1P = WS_MOD + 384 * 1024;
constexpr size_t WS_B1PP = WS_B1P + 2048;
constexpr size_t WS_WIN = 2 * MiB, WS_WOUT = 7 * MiB, WS_WGU = 9 * MiB, WS_WDN = 20 * MiB, WS_WKV = 26 * MiB, WS_WC1 = 27 * MiB, WS_WC2 = 29 * MiB;
constexpr size_t WS_HID = 30 * MiB;
constexpr size_t WS_KC = 34 * MiB;
constexpr size_t WS_VCT = 34 * MiB + 512 * 1024;
constexpr size_t WS_SSQC = 35 * MiB;
constexpr size_t WS_BM = 35 * MiB + 512 * 1024;
constexpr size_t WS_SSQY = 36 * MiB;
constexpr size_t WS_H = 40 * MiB, WS_Y = 104 * MiB, WS_AO = 168 * MiB, WS_R4 = 232 * MiB;
constexpr size_t WS_QN = WS_R4, WS_QD = WS_R4 + 32 * MiB, WS_QI = WS_R4 + 64 * MiB, WS_KD = WS_R4 + 96 * MiB, WS_VD = WS_R4 + 128 * MiB, WS_OCMP = WS_R4 + 160 * MiB;
constexpr size_t WS_KCR = WS_R4 + 192 * MiB;
constexpr size_t PLANE_BUF = 8 * MiB;
constexpr size_t WS_CRAW = WS_R4 + 240 * MiB;
constexpr size_t WS_KI = WS_R4 + 256 * MiB, WS_KR = WS_R4 + 260 * MiB, WS_GT = WS_R4 + 261 * MiB, WS_WI = WS_R4 + 264 * MiB, WS_MASKD = WS_R4 + 265 * MiB;
constexpr size_t WS_ACT = WS_R4;
constexpr size_t WS_Z = WS_AO;
constexpr size_t WS_SSQZ = 506 * MiB;
constexpr size_t WS_END = 510 * MiB;
constexpr int CW_BAR = 4096;
constexpr int CW_Q_IDX = 64, CW_Q_FLASH = 128;

constexpr int LDS_BYTES = 147456;
constexpr int MISC_OFF = LDS_BYTES - 256;

__device__ __forceinline__ unsigned cvt_pk_bf16(float lo, float hi) { unsigned r; asm volatile("v_cvt_pk_bf16_f32 %0, %1, %2" : "=v"(r) : "v"(lo), "v"(hi)); return r; }
__device__ __forceinline__ float bf2f(unsigned short h) { return __uint_as_float(((unsigned)h) << 16); }
__device__ __forceinline__ float bflo(unsigned w) { return __uint_as_float(w << 16); }
__device__ __forceinline__ float bfhi(unsigned w) { return __uint_as_float(w & 0xffff0000u); }
__device__ __forceinline__ u32x4 pack8(const float (&v)[8]) { u32x4 w; w.x = cvt_pk_bf16(v[0], v[1]); w.y = cvt_pk_bf16(v[2], v[3]); w.z = cvt_pk_bf16(v[4], v[5]); w.w = cvt_pk_bf16(v[6], v[7]); return w; }
__device__ __forceinline__ float fast_rcp(float x) { return __builtin_amdgcn_rcpf(x); }
__device__ __forceinline__ float fast_exp2(float x) { return __builtin_amdgcn_exp2f(x); }
__device__ __forceinline__ float swap_max(float v) { auto rr = __builtin_amdgcn_permlane32_swap(__float_as_uint(v), __float_as_uint(v), false, false); return fmaxf(__uint_as_float(rr[0]), __uint_as_float(rr[1])); }
__device__ __forceinline__ float swap_sum(float v) { auto rr = __builtin_amdgcn_permlane32_swap(__float_as_uint(v), __float_as_uint(v), false, false); return __uint_as_float(rr[0]) + __uint_as_float(rr[1]); }
__device__ __forceinline__ float max3f(float a, float b, float c) { float r; asm("v_max3_f32 %0, %1, %2, %3" : "=v"(r) : "v"(a), "v"(b), "v"(c)); return r; }
__device__ __forceinline__ float quad_xor1(float x) { return __int_as_float(__builtin_amdgcn_update_dpp(0, __float_as_int(x), 0xB1, 0xF, 0xF, true)); }
__device__ __forceinline__ float quad_xor2(float x) { return __int_as_float(__builtin_amdgcn_update_dpp(0, __float_as_int(x), 0x4E, 0xF, 0xF, true)); }
__device__ __forceinline__ float relu1(float x) { return __uint_as_float((unsigned)max((int)__float_as_uint(x), 0)); }
typedef __bf16 bf16x2_t __attribute__((ext_vector_type(2)));
__device__ __forceinline__ unsigned cvtpk_s(float lo, float hi) { f32x2 v = {lo, hi}; bf16x2_t b = __builtin_convertvector(v, bf16x2_t); return __builtin_bit_cast(unsigned, b); }
__device__ __forceinline__ int crow(int r, int hi) { return (r & 3) + 8 * (r >> 2) + 4 * hi; }
__device__ __forceinline__ float wave_sum(float v) {
#pragma unroll
    for (int o = 1; o < 64; o <<= 1) v += __shfl_xor(v, o);
    return v;
}

namespace pg8 {
constexpr int BM = 256, BK = 64, HALF = 128, HTB = HALF * BK * 2, STAGE_BYTES = 8 * HTB, NXCD = 8, WGM = 8;
__host__ __device__ __forceinline__ int lds_byte(int r, int c) { const int st = (r >> 4) * 2 + (c >> 5), rr = r & 15, cc = c & 31, ob = rr * 64 + cc * 2; return st * 1024 + (ob ^ (((ob >> 9) & 1) << 5)); }
__host__ __device__ __forceinline__ void stage_rc(int b, int& R, int& C) { const int st = b / 1024, sb = b % 1024, swz = sb ^ (((sb >> 9) & 1) << 5); R = (st >> 1) * 16 + swz / 64; C = (st & 1) * 32 + (swz % 64) / 2; }
__host__ __device__ __forceinline__ int perm32(int rho) { const int n = rho >> 4, i = rho & 15; return 8 * (i >> 2) + 4 * n + (i & 3); }

struct Unit { int pm, pn; };
struct Gemm { const bf16_t* A; const bf16_t* Bt; int M, N, K, lda; };

struct StaticOrder {
    int nM, nN, nwg, G, c;
    __host__ __device__ void init(int M, int N, int G_, int c_) { nM = M / BM; nN = N / BM; nwg = nM * nN; G = G_; c = c_; }
    __host__ __device__ bool next(int i, Unit& u) const {
        const long L = (long)i * G + c; if (L >= nwg) return false;
        int wgid = (int)L; { const int q = nwg / NXCD, r = nwg % NXCD, xcd = wgid % NXCD, off = wgid / NXCD; wgid = (xcd < r ? xcd * (q + 1) : r * (q + 1) + (xcd - r) * q) + off; }
        const int nig = WGM * nN, gid = wgid / nig, fm = gid * WGM, gsz = (nM - fm) < WGM ? (nM - fm) : WGM;
        u.pm = fm + ((wgid % nig) % gsz); u.pn = (wgid % nig) / gsz; return true;
    }
};
struct OneUnit {
    int pm; bool on;
    __device__ bool next(int i, Unit& u) const { if (i > 0 || !on) return false; u.pm = pm; u.pn = 0; return true; }
};

template <class Epi, class Sched, bool ALIGN_EPI>
__device__ __forceinline__ void gemm_phase(LAS unsigned char* lds, const Gemm g, const Sched& S, const Epi& E) {
    const int tid = threadIdx.x, wid = __builtin_amdgcn_readfirstlane(tid >> 6), lane = tid & 63, wr = wid >> 2, wc = wid & 3, fr = lane & 15, fq = lane >> 4;
    int K_ = g.K, lda_ = g.lda; asm volatile("" : "+s"(K_), "+s"(lda_));
    const int K = K_, nt = K / BK, lda = lda_;
    unsigned voffA[2], voffB[2];
#pragma unroll
    for (int i = 0; i < 2; ++i) { int R, C; stage_rc(tid * 16 + i * 8192, R, C); const int Rb = (R & ~31) + perm32(R & 31);
        voffA[i] = (unsigned)(R * lda + C) * 2u; voffB[i] = (unsigned)(Rb * K + C) * 2u; }
    const size_t kstep = (size_t)(BK * 2);
    const size_t hstepA = (size_t)HALF * lda * 2, hstepB = (size_t)HALF * K * 2;
    const size_t tstepA = 2 * hstepA, tstepB = 2 * hstepB;
    const unsigned ldsw = (unsigned)wid * 1024u;
    const int aoff = lds_byte(wr * 64 + fr, fq * 8), boff = lds_byte(wc * 32 + fr, fq * 8);
#define PG8_SA(b, h) (((b) * 2 + (h)) * HTB)
#define PG8_SB(b, h) ((4 + (b) * 2 + (h)) * HTB)
#define PG8_STAGE(bufoff, gbase, voff) do { _Pragma("unroll") for (int _i = 0; _i < 2; ++_i) \
        __builtin_amdgcn_global_load_lds((const unsigned*)((const char*)(gbase) + (voff)[_i]), (LAS unsigned*)(lds + (bufoff) + ldsw + _i * 8192), 16, 0, 0); } while (0)
#define PG8_LDA(dst, b, h) do { _Pragma("unroll") for (int m = 0; m < 4; ++m) _Pragma("unroll") for (int k = 0; k < 2; ++k) dst[m][k] = *(const LAS bf16x8*)(lds + PG8_SA(b, h) + aoff + m * 2048 + k * 1024); } while (0)
#define PG8_LDB(dst, b, h) do { _Pragma("unroll") for (int n = 0; n < 2; ++n) _Pragma("unroll") for (int k = 0; k < 2; ++k) dst[n][k] = *(const LAS bf16x8*)(lds + PG8_SB(b, h) + boff + n * 2048 + k * 1024); } while (0)
#define PG8_MMA(ai, bj, At, Bt) do { __builtin_amdgcn_s_setprio(1); _Pragma("unroll") for (int m = 0; m < 4; ++m) _Pragma("unroll") for (int n = 0; n < 2; ++n) _Pragma("unroll") for (int k = 0; k < 2; ++k) \
        acc[ai][bj][m][n] = __builtin_amdgcn_mfma_f32_16x16x32_bf16(Bt[n][k], At[m][k], acc[ai][bj][m][n], 0, 0, 0); __builtin_amdgcn_s_setprio(0); } while (0)
#define PG8_WAIT_V(n) asm volatile("s_waitcnt vmcnt(" #n ")" ::: "memory")
#define PG8_WAIT_L(n) asm volatile("s_waitcnt lgkmcnt(" #n ")" ::: "memory")
#define PG8_BAR __builtin_amdgcn_s_barrier()
#define PG8_SCHED __builtin_amdgcn_sched_barrier(0)
    Unit cur, nxt; int ui = 0;
    if (!S.next(0, cur)) return;
    f32x4 acc[2][2][4][2];
#pragma unroll
    for (int a = 0; a < 2; ++a)
#pragma unroll
        for (int b = 0; b < 2; ++b)
#pragma unroll
            for (int m = 0; m < 4; ++m)
#pragma unroll
                for (int n = 0; n < 2; ++n) acc[a][b][m][n] = (f32x4){0.f, 0.f, 0.f, 0.f};
    bf16x8 At[4][2], B0[2][2], B1[2][2];
    const char* cA = (const char*)g.A + (size_t)cur.pm * tstepA; const char* cB = (const char*)g.Bt + (size_t)cur.pn * tstepB;
    PG8_STAGE(PG8_SB(0, 0), cB, voffB); PG8_STAGE(PG8_SB(0, 1), cB + hstepB, voffB); PG8_STAGE(PG8_SA(0, 0), cA, voffA); PG8_STAGE(PG8_SA(0, 1), cA + hstepA, voffA);
    if (wr == 1) PG8_BAR;
    PG8_WAIT_V(2); PG8_BAR;
    PG8_STAGE(PG8_SB(1, 0), cB + kstep, voffB); PG8_STAGE(PG8_SA(1, 0), cA + kstep, voffA); PG8_STAGE(PG8_SB(1, 1), cB + hstepB + kstep, voffB);
    PG8_WAIT_V(6); PG8_BAR;
    for (;;) {
        const bool has_next = S.next(ui + 1, nxt);
        const char* nA = has_next ? (const char*)g.A + (size_t)nxt.pm * tstepA : cA; const char* nB = has_next ? (const char*)g.Bt + (size_t)nxt.pn * tstepB : cB;
        for (int t = 0; t < nt; t += 2) {
            const bool last = (t == nt - 2);
            const char* a1 = cA + (size_t)(t + 1) * kstep;
            const char* a2 = last ? nA : cA + (size_t)(t + 2) * kstep; const char* b2 = last ? nB : cB + (size_t)(t + 2) * kstep;
            const char* a3 = a2 + kstep; const char* b3 = b2 + kstep;
            PG8_LDB(B0, 0, 0); PG8_LDB(B1, 0, 1); PG8_SCHED; PG8_LDA(At, 0, 0); PG8_STAGE(PG8_SA(1, 1), a1 + hstepA, voffA);
            PG8_WAIT_V(8); PG8_WAIT_L(0); PG8_BAR; PG8_MMA(0, 0, At, B0); PG8_MMA(0, 1, At, B1); PG8_BAR; PG8_SCHED;
            PG8_LDA(At, 0, 1); PG8_STAGE(PG8_SB(0, 0), b2, voffB); PG8_STAGE(PG8_SB(0, 1), b2 + hstepB, voffB); PG8_STAGE(PG8_SA(0, 0), a2, voffA);
            PG8_WAIT_V(8); PG8_WAIT_L(0); PG8_BAR; PG8_MMA(1, 0, At, B0); PG8_MMA(1, 1, At, B1); PG8_BAR; PG8_SCHED;
            PG8_LDB(B0, 1, 0); PG8_LDB(B1, 1, 1); PG8_SCHED; PG8_LDA(At, 1, 0); PG8_STAGE(PG8_SA(0, 1), a2 + hstepA, voffA);
            PG8_WAIT_V(8); PG8_WAIT_L(0); PG8_BAR; PG8_MMA(0, 0, At, B0); PG8_MMA(0, 1, At, B1); PG8_BAR; PG8_SCHED;
            PG8_LDA(At, 1, 1); PG8_STAGE(PG8_SB(1, 0), b3, voffB); PG8_STAGE(PG8_SB(1, 1), b3 + hstepB, voffB); PG8_STAGE(PG8_SA(1, 0), a3, voffA);
            PG8_WAIT_V(8); PG8_WAIT_L(0); PG8_BAR; PG8_MMA(1, 0, At, B0); PG8_MMA(1, 1, At, B1); PG8_BAR; PG8_SCHED;
        }
        if constexpr (ALIGN_EPI) { if (wr == 0) PG8_BAR; }
        E(acc, cur, wr, wc, fr, fq);
        if (!has_next) break;
#pragma unroll
        for (int a = 0; a < 2; ++a)
#pragma unroll
            for (int b = 0; b < 2; ++b)
#pragma unroll
                for (int m = 0; m < 4; ++m)
#pragma unroll
                    for (int n = 0; n < 2; ++n) acc[a][b][m][n] = (f32x4){0.f, 0.f, 0.f, 0.f};
        cur = nxt; cA = nA; cB = nB; ++ui;
        if constexpr (ALIGN_EPI) { if (wr == 1) PG8_BAR; }
    }
    PG8_WAIT_V(0);
    if constexpr (!ALIGN_EPI) { if (wr == 0) PG8_BAR; }
    PG8_BAR;
#undef PG8_SA
#undef PG8_SB
#undef PG8_STAGE
#undef PG8_LDA
#undef PG8_LDB
#undef PG8_MMA
#undef PG8_WAIT_V
#undef PG8_WAIT_L
#undef PG8_BAR
#undef PG8_SCHED
}

#define EPI_ROWS_BEGIN _Pragma("unroll") for (int ai = 0; ai < 2; ++ai) _Pragma("unroll") for (int m = 0; m < 4; ++m) { const int row = u.pm * BM + ai * HALF + wr * 64 + m * 16 + fr;
#define EPI_ROWS_END asm volatile("" ::: "memory"); }
#define EPI_V8(v, ai, bj, m) float v[8] = {acc[ai][bj][m][0][0], acc[ai][bj][m][0][1], acc[ai][bj][m][0][2], acc[ai][bj][m][0][3], acc[ai][bj][m][1][0], acc[ai][bj][m][1][1], acc[ai][bj][m][1][2], acc[ai][bj][m][1][3]}

struct EpiInProj {
    unsigned char* ws;
    __device__ __forceinline__ void operator()(const f32x4 (&acc)[2][2][4][2], const Unit& u, int wr, int wc, int fr, int fq) const {
        const float* rope = (const float*)(ws + WS_ROPE);
#pragma unroll
        for (int bj = 0; bj < 2; ++bj) {
            const int seg = 2 * u.pn + bj;
            const int cl = wc * 32 + 8 * fq;
            const bool ropeseg = !(seg == 5 || seg == 7 || seg == 9 || seg == 14);
            const bool dorope = ropeseg && ((wc & 1) == 0);
            EPI_ROWS_BEGIN
                EPI_V8(v, ai, bj, m);
                if (dorope) {
                    float p[8];
#pragma unroll
                    for (int j = 0; j < 8; ++j) p[j] = __shfl_xor(v[j], 16);
                    if (fq < 2) {
                        const float* T = rope + (size_t)(row & (SEQ - 1)) * 16;
                        const f32x4 c0 = *(const f32x4*)T, c1 = *(const f32x4*)(T + 4), s0 = *(const f32x4*)(T + 8), s1 = *(const f32x4*)(T + 12);
                        const float cc[8] = {c0[0], c0[1], c0[2], c0[3], c1[0], c1[1], c1[2], c1[3]};
                        const float ss[8] = {s0[0], s0[1], s0[2], s0[3], s1[0], s1[1], s1[2], s1[3]};
                        const float sg = (fq == 0) ? -1.f : 1.f;
#pragma unroll
                        for (int j = 0; j < 8; ++j) v[j] = v[j] * cc[j] + sg * p[j] * ss[j];
                    }
                }
                if (seg < 4 || (seg >= 10 && seg < 14)) {
#pragma unroll
                    for (int j = 0; j < 8; ++j) v[j] *= C2;
                    bf16_t* base = (bf16_t*)(ws + (seg < 4 ? WS_QN : WS_QD));
                    const int sl = seg < 4 ? seg : seg - 10;
                    *(u32x4*)(base + (size_t)row * 512 + sl * 128 + cl) = pack8(v);
                } else if (seg >= 4 && seg < 10) {
                    bf16_t* base = (bf16_t*)(ws + WS_KCR + (size_t)(seg - 4) * PLANE_BUF);
                    const int g = cl >> 6, d = cl & 63;
                    const size_t prow = (size_t)row + (size_t)((row >> 11) + g) * SEQ;
                    if (seg == 7 || seg == 9) {
                        bf16_t* tp = base + (prow >> 6) * 4096 + (size_t)d * 64 + (prow & 63);
#pragma unroll
                        for (int j = 0; j < 8; ++j) tp[j * 64] = (bf16_t)(cvt_pk_bf16(v[j], 0.f) & 0xffffu);
                    } else {
                        *(u32x4*)(base + prow * 64 + d) = pack8(v);
                    }
                } else if (seg == 14) {
                    bf16_t* base = (bf16_t*)(ws + WS_CRAW);
                    *(u32x4*)(base + (size_t)row * 256 + cl) = pack8(v);
                    *(u32x4*)(base + (size_t)row * 256 + 128 + cl) = (u32x4){0u, 0u, 0u, 0u};
                    float s = 0.f;
#pragma unroll
                    for (int j = 0; j < 8; ++j) s += v[j] * v[j];
                    s += __shfl_xor(s, 16); s += __shfl_xor(s, 32);
                    if (fq == 0) ((float*)(ws + WS_SSQC))[(size_t)row * 4 + wc] = s;
                } else if (seg >= 15 && seg < 19) {
                    bf16_t* base = (bf16_t*)(ws + WS_QI);
                    *(u32x4*)(base + (size_t)row * 512 + (seg - 15) * 128 + cl) = pack8(v);
                } else {
                    if (cl < 64) { *(u32x4*)((bf16_t*)(ws + WS_KI) + (size_t)row * 64 + cl) = pack8(v); }
                    else if (cl < 80) { *(u32x4*)((bf16_t*)(ws + WS_KR) + (size_t)row * 16 + (cl - 64)) = pack8(v); }
                    else if (cl < 104) {
                        float* gp = (float*)(ws + WS_GT) + (size_t)row * 24 + (cl - 80);
                        f32x4 a, b;
                        a[0] = fast_rcp(1.f + __expf(-v[0])); a[1] = fast_rcp(1.f + __expf(-v[1])); a[2] = fast_rcp(1.f + __expf(-v[2])); a[3] = fast_rcp(1.f + __expf(-v[3]));
                        b[0] = fast_rcp(1.f + __expf(-v[4])); b[1] = fast_rcp(1.f + __expf(-v[5])); b[2] = fast_rcp(1.f + __expf(-v[6])); b[3] = fast_rcp(1.f + __expf(-v[7]));
                        *(f32x4*)gp = a; *(f32x4*)(gp + 4) = b;
                    } else if (cl < 112) {
                        const float sc = 0.35355339059327373f * 0.125f;
                        float* wp = (float*)(ws + WS_WI) + (size_t)row * 8;
                        *(f32x4*)wp = (f32x4){v[0] * sc, v[1] * sc, v[2] * sc, v[3] * sc}; *(f32x4*)(wp + 4) = (f32x4){v[4] * sc, v[5] * sc, v[6] * sc, v[7] * sc};
                    }
                }
            EPI_ROWS_END
        }
    }
};

struct EpiKvGen {
    unsigned char* ws;
    __device__ __forceinline__ void operator()(const f32x4 (&acc)[2][2][4][2], const Unit& u, int wr, int wc, int fr, int fq) const {
        const float* ssq = (const float*)(ws + WS_SSQC);
        const bf16_t* Kr = (const bf16_t*)(ws + WS_KR);
        EPI_ROWS_BEGIN
            const f32x4 q = *(const f32x4*)(ssq + (size_t)row * 4);
            const float rstd = 1.0f / sqrtf(((q[0] + q[1]) + (q[2] + q[3])) * (1.f / 128.f) + EPS);
#pragma unroll
            for (int bj = 0; bj < 2; ++bj) {
                const int col = u.pn * BM + bj * HALF + wc * 32 + 8 * fq;
                EPI_V8(v, ai, bj, m);
#pragma unroll
                for (int j = 0; j < 8; ++j) v[j] *= rstd;
                u32x4 w = pack8(v);
                if (col < 512) {
                    if ((col & 63) < 16) w = *(const u32x4*)(Kr + (size_t)row * 16 + (col & 63));
                    *(u32x4*)((bf16_t*)(ws + WS_KD) + (size_t)row * 512 + col) = w;
                } else {
                    const int hh = (col - 512) >> 6, d = col & 63, bb = row >> 11, sp = row & (SEQ - 1);
                    bf16_t* tp = (bf16_t*)(ws + WS_VD) + ((size_t)(bb * 8 + hh) * 32 + (sp >> 6)) * 4096 + (size_t)d * 64 + (sp & 63);
#pragma unroll
                    for (int j = 0; j < 8; ++j) tp[j * 64] = (bf16_t)(cvt_pk_bf16(v[j], 0.f) & 0xffffu);
                }
            }
        EPI_ROWS_END
    }
};

__device__ __forceinline__ float gelu_tanh(float x) {
    const float t = 0.7978845608028654f * (x + 0.044715f * x * x * x);
    const float e = __expf(2.f * t);
    const float th = 1.f - 2.f * fast_rcp(e + 1.f);
    return 0.5f * x * (1.f + th);
}
struct EpiHid {
    bf16_t* out; const float* bias;
    __device__ __forceinline__ void operator()(const f32x4 (&acc)[2][2][4][2], const Unit& u, int wr, int wc, int fr, int fq) const {
#pragma unroll
        for (int bj = 0; bj < 2; ++bj) {
            const int col = bj * HALF + wc * 32 + 8 * fq;
            const f32x4 b0 = *(const f32x4*)(bias + col), b1 = *(const f32x4*)(bias + col + 4);
            EPI_ROWS_BEGIN
                EPI_V8(v, ai, bj, m);
#pragma unroll
                for (int j = 0; j < 4; ++j) { v[j] = gelu_tanh(v[j] + b0[j]); v[4 + j] = gelu_tanh(v[4 + j] + b1[j]); }
                *(u32x4*)(out + (size_t)row * 256 + col) = pack8(v);
            EPI_ROWS_END
        }
    }
};
struct EpiCmp {
    unsigned char* ws; const float* b2; int kv;
    __device__ __forceinline__ void operator()(const f32x4 (&acc)[2][2][4][2], const Unit& u, int wr, int wc, int fr, int fq) const {
        const int col = wc * 32 + 8 * fq;
        if (col < 64) {
            const f32x4 b0 = *(const f32x4*)(b2 + col), b1 = *(const f32x4*)(b2 + col + 4);
            EPI_ROWS_BEGIN
                EPI_V8(v, ai, 0, m);
                const int n = row & 127;
#pragma unroll
                for (int j = 0; j < 4; ++j) { v[j] = (n == 127) ? 0.f : v[j] + b0[j]; v[4 + j] = (n == 127) ? 0.f : v[4 + j] + b1[j]; }
                if (kv == 0) { *(u32x4*)((bf16_t*)(ws + WS_KC) + (size_t)row * 64 + col) = pack8(v); }
                else { bf16_t* vt = (bf16_t*)(ws + WS_VCT) + (size_t)(row >> 7) * 64 * 128 + n;
#pragma unroll
                    for (int j = 0; j < 8; ++j) vt[(size_t)(col + j) * 128] = (bf16_t)(cvt_pk_bf16(v[j], 0.f) & 0xffffu); }
            EPI_ROWS_END
        }
    }
};
struct EpiY {
    bf16_t* out; float* ssq;
    __device__ __forceinline__ void operator()(const f32x4 (&acc)[2][2][4][2], const Unit& u, int wr, int wc, int fr, int fq) const {
#pragma unroll
        for (int bj = 0; bj < 2; ++bj) {
            const int col = u.pn * BM + bj * HALF + wc * 32 + 8 * fq;
            EPI_ROWS_BEGIN
                EPI_V8(v, ai, bj, m);
                float s = 0.f;
#pragma unroll
                for (int j = 0; j < 8; ++j) s += v[j] * v[j];
                s += __shfl_xor(s, 16); s += __shfl_xor(s, 32);
                if (fq == 0) ssq[(size_t)row * 32 + u.pn * 8 + bj * 4 + wc] = s;
                *(u32x4*)(out + (size_t)row * DM + col) = pack8(v);
            EPI_ROWS_END
        }
    }
};
struct EpiSwiglu {
    bf16_t* out;
    __device__ __forceinline__ void operator()(const f32x4 (&acc)[2][2][4][2], const Unit& u, int wr, int wc, int fr, int fq) const {
        const int col = u.pn * HALF + wc * 32 + 8 * fq;
        EPI_ROWS_BEGIN
            EPI_V8(g, ai, 0, m); EPI_V8(p, ai, 1, m);
            float v[8];
#pragma unroll
            for (int j = 0; j < 8; ++j) v[j] = g[j] * fast_rcp(1.f + __expf(-g[j])) * p[j];
            *(u32x4*)(out + (size_t)row * DFF + col) = pack8(v);
        EPI_ROWS_END
    }
};
}

#define XB_TMO      128
#define XB_XCNT(j)  (256  + 64 * (j))
#define XB_XSUB(j)  (1280 + 64 * (j))
#define XB_XGEN(j)  (2304 + 64 * (j))
#define XB_TOP      3328
#define XB_TOPGEN   3392
#define XCD_BAR_WORDS 3456
#define XB_SPIN_CAP (1u << 18)
__device__ __forceinline__ unsigned xb_ld(unsigned* p)              { return __hip_atomic_load(p, __ATOMIC_RELAXED, __HIP_MEMORY_SCOPE_AGENT); }
__device__ __forceinline__ unsigned xb_add(unsigned* p, unsigned v) { return __hip_atomic_fetch_add(p, v, __ATOMIC_RELAXED, __HIP_MEMORY_SCOPE_AGENT); }
__device__ __forceinline__ unsigned xb_xcc_id() { return (unsigned)__builtin_amdgcn_s_getreg((3 << 11) | 20) & 0xFu; }
#define XB_SPIN(cond, bar) do { unsigned _sp = 0; while (cond) { __builtin_amdgcn_s_sleep(1); \
    if ((++_sp & 255u) == 0u) { if (xb_ld(&(bar)[XB_TMO])) break; if (_sp > XB_SPIN_CAP) { atomicAdd(&(bar)[XB_TMO], 1u); break; } } } } while (0)
struct XcdBarrier { unsigned* bar; unsigned x; volatile LAS unsigned* st; };
__device__ __forceinline__ XcdBarrier xcd_barrier_post(unsigned* bar, volatile LAS unsigned* st) {
    XcdBarrier b; b.bar = bar; b.x = xb_xcc_id(); b.st = st;
    if (threadIdx.x == 0) (void)xb_add(&bar[XB_XCNT(b.x)], 1u);
    return b;
}
__device__ __forceinline__ void xcd_barrier_complete(unsigned* bar, unsigned x, unsigned& nloc, unsigned& nx) {
    const unsigned G = gridDim.x * gridDim.y * gridDim.z;
    unsigned sum, cnt, mine, sp = 0u;
    for (;;) {
        sum = 0u; cnt = 0u; mine = 0u;
#pragma unroll
        for (unsigned j = 0; j < 16; ++j) { const unsigned c = xb_ld(&bar[XB_XCNT(j)]); sum += c; cnt += (c > 0u) ? 1u : 0u; mine = (j == x) ? c : mine; }
        if (sum == G) break;
        __builtin_amdgcn_s_sleep(1);
        if ((++sp & 255u) == 0u) { if (xb_ld(&bar[XB_TMO])) break; if (sp > XB_SPIN_CAP) { atomicAdd(&bar[XB_TMO], 1u); break; } }
    }
    nloc = mine > 0u ? mine : 1u; nx = cnt > 0u ? cnt : 1u;
}
__device__ __forceinline__ void xcd_barrier(const XcdBarrier& b) {
    asm volatile("s_waitcnt vmcnt(0)" ::: "memory");
    __syncthreads();
    if (threadIdx.x == 0) {
        unsigned* bar = b.bar;
        __builtin_amdgcn_s_waitcnt(0);
        unsigned nloc = b.st[0], nx = b.st[1];
        if (nloc == 0u) { xcd_barrier_complete(bar, b.x, nloc, nx); b.st[0] = nloc; b.st[1] = nx; }
        const unsigned old = xb_add(&bar[XB_XSUB(b.x)], 1u);
        const unsigned gen = old / nloc;
        if (old + 1u == (gen + 1u) * nloc) {
            __builtin_amdgcn_fence(__ATOMIC_RELEASE, "agent");
            asm volatile("s_waitcnt vmcnt(0)" ::: "memory");
            const unsigned og = xb_add(&bar[XB_TOP], 1u);
            const unsigned tg = og / nx;
            if (og + 1u == (tg + 1u) * nx) xb_add(&bar[XB_TOPGEN], 1u);
            else XB_SPIN(xb_ld(&bar[XB_TOPGEN]) == tg, bar);
            __builtin_amdgcn_fence(__ATOMIC_ACQUIRE, "agent");
            xb_add(&bar[XB_XGEN(b.x)], 1u);
            asm volatile("s_waitcnt vmcnt(0)" ::: "memory");
        } else {
            XB_SPIN(xb_ld(&bar[XB_XGEN(b.x)]) == gen, bar);
            __builtin_amdgcn_fence(__ATOMIC_ACQUIRE, "agent");
            asm volatile("s_waitcnt vmcnt(0)" ::: "memory");
        }
    }
    __syncthreads();
}

struct Args { const float* in[20]; float* out; unsigned char* ws; int ph_lo, ph_hi, li, pad; };
enum { I_X = 0, I_C, I_WADA, I_BADA, I_GPM, I_GQM, I_GPF, I_GQF, I_WIN, I_PE, I_CW1, I_CB1, I_CW2, I_CB2, I_GKV, I_WUK, I_WUV, I_WOUT, I_WGU, I_WDN };

struct ColSrc { const float* p; int ld; int kmax; };
__device__ __forceinline__ ColSrc col_src(const Args& a, int mat, int n) {
    ColSrc c; c.p = nullptr; c.ld = 0; c.kmax = 1 << 30;
    switch (mat) {
    case 0: { int sc;
        if (n < 1280) sc = n; else if (n < 1920) sc = n + 24; else if (n < 2496) sc = n + 40; else if (n < 2512) sc = n - 552; else if (n < 2536) sc = n - 1232; else if (n < 2544) sc = n; else sc = -1;
        if (sc >= 0) c.p = a.in[I_WIN] + sc; c.ld = 2544; break; }
    case 1: c.p = a.in[I_WOUT] + n; c.ld = DM; break;
    case 2: { const int pn = n >> 8, jj = n & 255, bj = jj >> 7, col = pn * 128 + (jj & 127); c.p = a.in[I_WGU] + bj * DFF + col; c.ld = NGU; break; }
    case 3: c.p = a.in[I_WDN] + n; c.ld = DM; break;
    case 4: { c.kmax = 128;
        if (n < 512) { const int h = n >> 6, d = n & 63; if (d >= 16) c.p = a.in[I_WUK] + (size_t)h * 128 * 48 + (d - 16); c.ld = 48; }
        else { const int h = (n - 512) >> 6, d = n & 63; c.p = a.in[I_WUV] + (size_t)h * 128 * 64 + d; c.ld = 64; }
        break; }
    case 5: case 6: { if (n < 128) c.p = a.in[I_CW1] + (size_t)(mat - 5) * 2048 * 128 + n; c.ld = 128; break; }
    default: { c.kmax = 128; if (n < 64) c.p = a.in[I_CW2] + (size_t)(mat - 7) * 128 * 64 + n; c.ld = 64; break; }
    }
    return c;
}
__device__ __forceinline__ void p0_transpose_item(const Args& a, int mat, int K, bf16_t* WT, int kb, int nb, LAS float* scr, int lane) {
    const int k0 = 64 * kb, n0 = 32 * nb;
    const ColSrc c = col_src(a, mat, n0 + (lane & 31));
    const bool live = (c.p != nullptr) && (k0 < c.kmax);
    const float* p = live ? c.p + (size_t)(k0 + (lane >> 5)) * c.ld : a.in[I_GKV];
    const size_t step = live ? (size_t)2 * c.ld : 0;
    float v[32];
#pragma unroll
    for (int i = 0; i < 32; ++i) v[i] = p[(size_t)i * step];
    if (mat == 4) {
#pragma unroll
        for (int i = 0; i < 32; ++i) v[i] *= a.in[I_GKV][(k0 + 2 * i + (lane >> 5)) & 127];
    }
#pragma unroll
    for (int i = 0; i < 32; ++i) scr[(2 * i + (lane >> 5)) * 33 + (lane & 31)] = live ? v[i] : 0.f;
    asm volatile("s_waitcnt lgkmcnt(0)" ::: "memory");
    const int cc = lane & 7;
#pragma unroll
    for (int j = 0; j < 4; ++j) { const int n = (lane >> 3) + 8 * j; const LAS float* sp = scr + (8 * cc) * 33 + n;
        u32x4 o; o.x = cvt_pk_bf16(sp[0 * 33], sp[1 * 33]); o.y = cvt_pk_bf16(sp[2 * 33], sp[3 * 33]); o.z = cvt_pk_bf16(sp[4 * 33], sp[5 * 33]); o.w = cvt_pk_bf16(sp[6 * 33], sp[7 * 33]);
        *(u32x4*)(WT + (size_t)(n0 + n) * K + k0 + 8 * cc) = o; }
    asm volatile("s_waitcnt lgkmcnt(0)" ::: "memory");
}
__device__ __forceinline__ void p0_prologue(const Args& a, LAS unsigned char* lds) {
    unsigned char* ws = a.ws;
    const int tid = threadIdx.x, lane = tid & 63, wave = tid >> 6, G = gridDim.x, blk = blockIdx.x;
    __syncthreads();
    {
        LAS float* cact = (LAS float*)lds;
        LAS float* red = (LAS float*)(lds + 65536);
        for (int i = tid; i < NB * DM; i += 512) { const float c = a.in[I_C][i]; cact[i] = c * fast_rcp(1.f + __expf(-c)); }
        __syncthreads();
        for (int cb = blk; cb < 256; cb += G) {
            const int ks = tid >> 5, jj = tid & 31, col = cb * 24 + jj;
            float accv[16];
#pragma unroll
            for (int b = 0; b < 16; ++b) accv[b] = 0.f;
            if (jj < 24) {
                float wv[64];
#pragma unroll
                for (int kk = 0; kk < 64; ++kk) wv[kk] = a.in[I_WADA][(size_t)(ks * 64 + kk) * 6144 + col];
#pragma unroll
                for (int kk = 0; kk < 64; ++kk)
#pragma unroll
                    for (int b = 0; b < 16; ++b) accv[b] += cact[b * DM + ks * 64 + kk] * wv[kk];
#pragma unroll
                for (int b = 0; b < 16; ++b) red[(ks * 16 + b) * 24 + jj] = accv[b];
            }
            __syncthreads();
            if (tid < 384) { const int b = tid / 24, j2 = tid % 24; float s = 0.f;
#pragma unroll
                for (int k2 = 0; k2 < 16; ++k2) s += red[(k2 * 16 + b) * 24 + j2];
                ((float*)(ws + WS_MOD))[(size_t)b * 6144 + cb * 24 + j2] = s + a.in[I_BADA][cb * 24 + j2]; }
            __syncthreads();
        }
    }
    if (blk < 32) {
        LAS float* red = (LAS float*)lds;
        const int kv = blk >> 4, ks = blk & 15, j = tid & 127, q = tid >> 7; float s = 0.f;
        const float* pe = a.in[I_PE] + (size_t)kv * 2048 + ks * 128 + q * 32;
        const float* w1 = a.in[I_CW1] + ((size_t)kv * 2048 + ks * 128 + q * 32) * 128 + j;
        float wv[32];
#pragma unroll
        for (int k = 0; k < 32; ++k) wv[k] = w1[(size_t)k * 128];
#pragma unroll
        for (int k = 0; k < 32; ++k) s += pe[k] * wv[k];
        red[tid] = s; __syncthreads();
        if (tid < 128) ((float*)(ws + WS_B1PP))[(kv * 16 + ks) * 128 + tid] = (red[tid] + red[tid + 128]) + (red[tid + 256] + red[tid + 384]);
        __syncthreads();
    }
    for (int e = blk * 512 + tid; e < SEQ * 8; e += G * 512) {
        const int pos = e >> 3, i = e & 7;
        const float inv = (float)exp(-(double)i * 0.125 * 13.122363377404328);
        const float ang = (float)pos * inv;
        double x = (double)ang; const double n = rint(x * 0.15915494309189535); x = x - n * 6.283185307179586;
        const double x2 = x * x;
        double s = 0.0, c = 0.0, ts = x, tc = 1.0;
#pragma unroll
        for (int q = 0; q < 14; ++q) { s += ts; c += tc; ts = -ts * x2 / (double)((2 * q + 2) * (2 * q + 3)); tc = -tc * x2 / (double)((2 * q + 1) * (2 * q + 2)); }
        ((float*)(ws + WS_ROPE))[pos * 16 + i] = (float)c; ((float*)(ws + WS_ROPE))[pos * 16 + 8 + i] = (float)s;
    }
    {
        LAS float* scr = (LAS float*)(lds + wave * 16384);
        const int gw = blk * 8 + wave, NGW = G * 8;
        constexpr int I0 = 16 * 80, I1 = 16 * 32, I2 = 16 * 176, I3 = 44 * 32, I4 = 4 * 32, I5 = 32 * 8, I7 = 4 * 8;
        constexpr int NIT = I0 + I1 + I2 + I3 + I4 + 2 * I5 + 2 * I7;
        for (int it = gw; it < NIT; it += NGW) {
            int r = it;
            if (r < I0) { p0_transpose_item(a, 0, 1024, (bf16_t*)(ws + WS_WIN), r / 80, r % 80, scr, lane); continue; } r -= I0;
            if (r < I1) { p0_transpose_item(a, 1, 1024, (bf16_t*)(ws + WS_WOUT), r / 32, r % 32, scr, lane); continue; } r -= I1;
            if (r < I2) { p0_transpose_item(a, 2, 1024, (bf16_t*)(ws + WS_WGU), r / 176, r % 176, scr, lane); continue; } r -= I2;
            if (r < I3) { p0_transpose_item(a, 3, 2816, (bf16_t*)(ws + WS_WDN), r / 32, r % 32, scr, lane); continue; } r -= I3;
            if (r < I4) { p0_transpose_item(a, 4, 256, (bf16_t*)(ws + WS_WKV), r / 32, r % 32, scr, lane); continue; } r -= I4;
            if (r < I5) { p0_transpose_item(a, 5, 2048, (bf16_t*)(ws + WS_WC1), r / 8, r % 8, scr, lane); continue; } r -= I5;
            if (r < I5) { p0_transpose_item(a, 6, 2048, (bf16_t*)(ws + WS_WC1) + 256 * 2048, r / 8, r % 8, scr, lane); continue; } r -= I5;
            if (r < I7) { p0_transpose_item(a, 7, 256, (bf16_t*)(ws + WS_WC2), r / 8, r % 8, scr, lane); continue; } r -= I7;
            p0_transpose_item(a, 8, 256, (bf16_t*)(ws + WS_WC2) + 256 * 256, r / 8, r % 8, scr, lane);
        }
    }
}

__device__ __forceinline__ void p1_hnorm(const Args& a) {
    unsigned char* ws = a.ws; const float* mod = (const float*)(ws + WS_MOD);
    if (blockIdx.x == 0 && threadIdx.x < 256) {
        const int kv = threadIdx.x >> 7, j = threadIdx.x & 127; float s = a.in[I_CB1][kv * 128 + j];
        for (int ks = 0; ks < 16; ++ks) s += ((const float*)(ws + WS_B1PP))[(kv * 16 + ks) * 128 + j];
        ((float*)(ws + WS_B1P))[kv * 256 + j] = s; ((float*)(ws + WS_B1P))[kv * 256 + 128 + j] = 0.f;
    }
    const int lane = threadIdx.x & 63, gw = blockIdx.x * 8 + (threadIdx.x >> 6), NGW = gridDim.x * 8;
    f32x4 v[2][4], vn[2][4];
#pragma unroll
    for (int u = 0; u < 2; ++u) { const int row = min(gw + u * NGW, MTOK - 1); const f32x4* xr = (const f32x4*)(a.in[I_X] + (size_t)row * DM) + lane;
#pragma unroll
        for (int j = 0; j < 4; ++j) v[u][j] = __builtin_nontemporal_load(xr + 64 * j); }
#pragma unroll 1
    for (int row0 = gw; row0 < MTOK; row0 += 2 * NGW) {
#pragma unroll
        for (int u = 0; u < 2; ++u) { const int row = min(row0 + (2 + u) * NGW, MTOK - 1); const f32x4* xr = (const f32x4*)(a.in[I_X] + (size_t)row * DM) + lane;
#pragma unroll
            for (int j = 0; j < 4; ++j) vn[u][j] = __builtin_nontemporal_load(xr + 64 * j); }
#pragma unroll
        for (int u = 0; u < 2; ++u) {
            const int row = row0 + u * NGW;
            if (row < MTOK) {
                const int b = row >> 11; float s = 0.f;
#pragma unroll
                for (int j = 0; j < 4; ++j) s += (v[u][j][0] * v[u][j][0] + v[u][j][1] * v[u][j][1]) + (v[u][j][2] * v[u][j][2] + v[u][j][3] * v[u][j][3]);
                const float rstd = 1.0f / sqrtf(wave_sum(s) * (1.f / DM) + EPS);
                u32x2* o = (u32x2*)((bf16_t*)(ws + WS_H) + (size_t)row * DM) + lane;
#pragma unroll
                for (int j = 0; j < 4; ++j) { const int c = 256 * j + 4 * lane;
                    const f32x4 g = *(const f32x4*)(a.in[I_GPM] + c), sh = *(const f32x4*)(mod + (size_t)b * 6144 + c), sc = *(const f32x4*)(mod + (size_t)b * 6144 + 1024 + c);
                    float h[4];
#pragma unroll
                    for (int e = 0; e < 4; ++e) h[e] = (v[u][j][e] * rstd * g[e]) * (1.f + sc[e]) + sh[e];
                    o[64 * j] = (u32x2){cvt_pk_bf16(h[0], h[1]), cvt_pk_bf16(h[2], h[3])}; }
            }
        }
#pragma unroll
        for (int u = 0; u < 2; ++u)
#pragma unroll
            for (int j = 0; j < 4; ++j) v[u][j] = vn[u][j];
    }
}

constexpr int SC_STRIDE = 2052;
__device__ __forceinline__ unsigned fkey(float f) { const unsigned u = __float_as_uint(f); return u ^ ((unsigned)((int)u >> 31) | 0x80000000u); }
__device__ __forceinline__ int count_ge8(unsigned k0, unsigned k1, unsigned k2, unsigned k3, unsigned k4, unsigned k5, unsigned k6, unsigned k7, unsigned c) {
    u64 m0, m1, m2, m3, m4, m5, m6, m7;
    asm("v_cmp_ge_u32_e64 %0, %8, %16\n\tv_cmp_ge_u32_e64 %1, %9, %16\n\tv_cmp_ge_u32_e64 %2, %10, %16\n\tv_cmp_ge_u32_e64 %3, %11, %16\n\t"
        "v_cmp_ge_u32_e64 %4, %12, %16\n\tv_cmp_ge_u32_e64 %5, %13, %16\n\tv_cmp_ge_u32_e64 %6, %14, %16\n\tv_cmp_ge_u32_e64 %7, %15, %16"
        : "=&s"(m0), "=&s"(m1), "=&s"(m2), "=&s"(m3), "=&s"(m4), "=&s"(m5), "=&s"(m6), "=&s"(m7)
        : "v"(k0), "v"(k1), "v"(k2), "v"(k3), "v"(k4), "v"(k5), "v"(k6), "v"(k7), "v"(c));
    return (__popcll(m0) + __popcll(m1)) + (__popcll(m2) + __popcll(m3)) + ((__popcll(m4) + __popcll(m5)) + (__popcll(m6) + __popcll(m7)));
}
__device__ __forceinline__ void idx_unit(const Args& a, LAS unsigned char* lds, int b, int tile) {
    unsigned char* ws = a.ws;
    const int tid = threadIdx.x, lane = tid & 63, wid = __builtin_amdgcn_readfirstlane(tid >> 6), t0 = tile * 16;
    LAS float* SC = (LAS float*)lds;
#ifndef MK_IDX_REP_SCORE
#define MK_IDX_REP_SCORE 1
#endif
#ifndef MK_IDX_REP_SEL
#define MK_IDX_REP_SEL 1
#endif
    const bool need_scores = (t0 + 15) >= 256;
#pragma unroll 1
    for (int rs_ = 0; rs_ < MK_IDX_REP_SCORE; ++rs_)
    if (need_scores) {
        const int tq = lane & 15, fq = lane >> 4;
        const size_t trow = (size_t)b * SEQ + t0 + tq;
        const bf16_t* Qi = (const bf16_t*)(ws + WS_QI) + trow * 512;
        bf16x8 qb[8][2]; float wv[8];
#pragma unroll
        for (int h = 0; h < 8; ++h) { qb[h][0] = *(const bf16x8*)(Qi + h * 64 + 8 * fq); qb[h][1] = *(const bf16x8*)(Qi + h * 64 + 32 + 8 * fq); }
        { const f32x4 w0 = *(const f32x4*)((const float*)(ws + WS_WI) + trow * 8), w1 = *(const f32x4*)((const float*)(ws + WS_WI) + trow * 8 + 4);
          wv[0] = w0[0]; wv[1] = w0[1]; wv[2] = w0[2]; wv[3] = w0[3]; wv[4] = w1[0]; wv[5] = w1[1]; wv[6] = w1[2]; wv[7] = w1[3]; }
        const bf16_t* Ki = (const bf16_t*)(ws + WS_KI) + (size_t)b * SEQ * 64 + (size_t)tq * 64 + 8 * fq;
        bf16x8 kf[4][2];
#pragma unroll
        for (int u = 0; u < 4; ++u) { const int cs = min(wid + 8 * u, tile); kf[u][0] = *(const bf16x8*)(Ki + (size_t)cs * 1024); kf[u][1] = *(const bf16x8*)(Ki + (size_t)cs * 1024 + 32); }
#pragma unroll 1
        for (int st = wid; st <= tile; st += 32) {
#pragma unroll
            for (int u = 0; u < 4; ++u) {
                const int cs = st + 8 * u;
                const bf16x8 k0 = kf[u][0], k1 = kf[u][1];
                f32x4 sc = {0.f, 0.f, 0.f, 0.f};
                if (cs <= tile) {
                    f32x4 d[8];
#pragma unroll
                    for (int h = 0; h < 8; ++h) {
                        d[h] = __builtin_amdgcn_mfma_f32_16x16x32_bf16(k0, qb[h][0], (f32x4){0.f, 0.f, 0.f, 0.f}, 0, 0, 0);
                        d[h] = __builtin_amdgcn_mfma_f32_16x16x32_bf16(k1, qb[h][1], d[h], 0, 0, 0);
                    }
#pragma unroll
                    for (int h = 0; h < 8; ++h)
#pragma unroll
                        for (int j = 0; j < 4; ++j) sc[j] += wv[h] * relu1(d[h][j]);
                }
                { const int cn = min(cs + 32, tile); kf[u][0] = *(const bf16x8*)(Ki + (size_t)cn * 1024); kf[u][1] = *(const bf16x8*)(Ki + (size_t)cn * 1024 + 32); }
                if (cs <= tile) *(LAS u32x4*)(SC + tq * SC_STRIDE + cs * 16 + 4 * fq) = (u32x4){fkey(sc[0]), fkey(sc[1]), fkey(sc[2]), fkey(sc[3])};
            }
        }
    }
    __syncthreads();
#pragma unroll 1
    for (int rsel_ = 0; rsel_ < MK_IDX_REP_SEL; ++rsel_) {
    const LAS unsigned* KEY = (const LAS unsigned*)lds;
    const int ta = t0 + 2 * wid, tb = ta + 1;
    u64* moa = (u64*)(ws + WS_MASKD) + ((size_t)b * SEQ + ta) * 32;
    unsigned wlo_a = 0u, whi_a = 0u, wlo_b = 0u, whi_b = 0u;
#define IDX_PUT(WLO, WHI, i, w) do { const unsigned lo_ = (unsigned)(w), hi_ = (unsigned)((w) >> 32); \
        asm volatile("s_nop 1\n\tv_writelane_b32 %0, %2, %4\n\tv_writelane_b32 %1, %3, %4" : "+v"(WLO), "+v"(WHI) : "s"(lo_), "s"(hi_), "i"(i)); } while (0)
    if (tb < 256) {
#pragma unroll
        for (int i = 0; i < 32; ++i) { const u64 wa = __ballot(64 * i + lane <= ta), wb = __ballot(64 * i + lane <= tb); IDX_PUT(wlo_a, whi_a, i, wa); IDX_PUT(wlo_b, whi_b, i, wb); }
    } else {
        unsigned ka[32], kb[32];
        const int nreg = (tb >> 6) + 1;
#pragma unroll
        for (int i = 0; i < 32; ++i) { const int sidx = 64 * i + lane;
            if (i < nreg) { const unsigned va = KEY[(2 * wid) * SC_STRIDE + sidx], vb = KEY[(2 * wid + 1) * SC_STRIDE + sidx]; ka[i] = (sidx <= ta) ? va : 0u; kb[i] = (sidx <= tb) ? vb : 0u; }
            else { ka[i] = 0u; kb[i] = 0u; } }
        unsigned Ta = 0u, Tb = 0u; bool ea = false, eb = false;
#pragma unroll 1
        for (int bit = 31; bit >= 0; --bit) {
            if (!ea) {
                const unsigned c = Ta | (1u << bit); int cnt = 0;
#pragma unroll
                for (int i0 = 0; i0 < 32; i0 += 8) if (i0 < nreg) cnt += count_ge8(ka[i0], ka[i0 + 1], ka[i0 + 2], ka[i0 + 3], ka[i0 + 4], ka[i0 + 5], ka[i0 + 6], ka[i0 + 7], c);
                if (cnt >= 256) { Ta = c; ea = (cnt == 256); }
            }
            if (!eb) {
                const unsigned c = Tb | (1u << bit); int cnt = 0;
#pragma unroll
                for (int i0 = 0; i0 < 32; i0 += 8) if (i0 < nreg) cnt += count_ge8(kb[i0], kb[i0 + 1], kb[i0 + 2], kb[i0 + 3], kb[i0 + 4], kb[i0 + 5], kb[i0 + 6], kb[i0 + 7], c);
                if (cnt >= 256) { Tb = c; eb = (cnt == 256); }
            }
            if (ea && eb) break;
        }
#define IDX_FINISH(K, T, EX, WLO, WHI) do { \
            if (EX) { _Pragma("unroll") for (int i = 0; i < 32; ++i) { const u64 w_ = __ballot(K[i] >= T); IDX_PUT(WLO, WHI, i, w_); } } \
            else { int ngt_ = 0; _Pragma("unroll") for (int i = 0; i < 32; ++i) ngt_ += __popcll(__ballot(K[i] > T)); \
                int need_ = 256 - ngt_;                            \
                _Pragma("unroll") for (int i = 0; i < 32; ++i) { const bool gt_ = K[i] > T, eq_ = K[i] == T; const u64 em_ = __ballot(eq_); \
                    const int before_ = __popcll(em_ & ((1ull << lane) - 1ull)); const bool take_ = eq_ && (before_ < need_); const u64 w_ = __ballot(gt_ || take_); \
                    need_ -= __popcll(em_); if (need_ < 0) need_ = 0; IDX_PUT(WLO, WHI, i, w_); } } } while (0)
        IDX_FINISH(ka, Ta, ea, wlo_a, whi_a);
        IDX_FINISH(kb, Tb, eb, wlo_b, whi_b);
#undef IDX_FINISH
    }
#undef IDX_PUT
    if (lane < 32) { moa[lane] = ((u64)whi_a << 32) | wlo_a; moa[32 + lane] = ((u64)whi_b << 32) | wlo_b; }
    }
    __syncthreads();
}

constexpr int PS_STRIDE = 132;
constexpr int CMP_KC_OFF = 36864, CMP_KC_STR = 144, CMP_VT_OFF = CMP_KC_OFF + 128 * CMP_KC_STR, CMP_VT_STR = 264;
__device__ __forceinline__ void cmp_unit(const Args& a, LAS unsigned char* lds, int plane, int tt) {
    unsigned char* ws = a.ws;
    const int tid = threadIdx.x, lane = tid & 63, wid = __builtin_amdgcn_readfirstlane(tid >> 6), r32 = lane & 31, hi = lane >> 5;
    const int b = plane >> 1, g = plane & 1, t0 = tt * 64;
    const int tl = r32 >> 2, hd = r32 & 3, t = t0 + 8 * wid + tl;
    const size_t trow = (size_t)b * SEQ + t;
    const int nmax = (t0 + 32) >> 4, nbmax = nmax >> 5;
    const bf16_t* Qn = (const bf16_t*)(ws + WS_QN) + trow * 512 + (g * 4 + hd) * 64;
    bf16x8 qr[4];
#pragma unroll
    for (int d0 = 0; d0 < 4; ++d0) qr[d0] = *(const bf16x8*)(Qn + d0 * 16 + hi * 8);
    const LAS unsigned char* KC = lds + CMP_KC_OFF;
    f32x16 p[4];
    {
        bf16x8 kf[4][4];
#pragma unroll
        for (int nb = 0; nb < 4; ++nb)
#pragma unroll
            for (int d0 = 0; d0 < 4; ++d0) kf[nb][d0] = *(const LAS bf16x8*)(KC + (nb * 32 + r32) * CMP_KC_STR + (d0 * 16 + hi * 8) * 2);
#pragma unroll
        for (int nb = 0; nb < 4; ++nb) {
            p[nb] = (f32x16){0.f, 0.f, 0.f, 0.f, 0.f, 0.f, 0.f, 0.f, 0.f, 0.f, 0.f, 0.f, 0.f, 0.f, 0.f, 0.f};
            if (nb <= nbmax) {
#pragma unroll
                for (int d0 = 0; d0 < 4; ++d0) p[nb] = __builtin_amdgcn_mfma_f32_32x32x16_bf16(kf[nb][d0], qr[d0], p[nb], 0, 0, 0);
            }
        }
    }
    const LAS unsigned char* VT = lds + CMP_VT_OFF;
    u32x2 vlo[4][2][2], vhh[4][2][2];
#pragma unroll
    for (int nb = 0; nb < 4; ++nb)
#pragma unroll
        for (int ks = 0; ks < 2; ++ks)
#pragma unroll
            for (int d0 = 0; d0 < 2; ++d0) { const LAS unsigned char* vp = VT + (d0 * 32 + r32) * CMP_VT_STR + (nb * 32 + ks * 16 + 4 * hi) * 2; vlo[nb][ks][d0] = *(const LAS u32x2*)vp; vhh[nb][ks][d0] = *(const LAS u32x2*)(vp + 16); }
    const float* Gt = (const float*)(ws + WS_GT);
    float rm = NEGBIG;
#pragma unroll
    for (int nb = 0; nb < 4; ++nb)
#pragma unroll
        for (int r = 0; r < 16; ++r) { const int n = nb * 32 + crow(r, hi); const bool valid = (16 * n + 31) <= t; const float sv = valid ? p[nb][r] : NEGBIG; p[nb][r] = sv; rm = fmaxf(rm, sv); }
    rm = swap_max(rm);
    if (rm < -1e29f) rm = 1e30f;
    float ls = 0.f;
#pragma unroll
    for (int nb = 0; nb < 4; ++nb)
#pragma unroll
        for (int r = 0; r < 16; ++r) { const float e = fast_exp2(p[nb][r] - rm); p[nb][r] = e; ls += e; }
    ls = swap_sum(ls);
    const float inv = 1.0f / fmaxf(ls, 1e-30f);
    LAS float* PS = (LAS float*)lds + wid * 8 * PS_STRIDE;
#pragma unroll
    for (int nb = 0; nb < 4; ++nb)
#pragma unroll
        for (int rg = 0; rg < 4; ++rg) {
            f32x4 sm;
#pragma unroll
            for (int e = 0; e < 4; ++e) { const float pn = p[nb][4 * rg + e] * inv; p[nb][4 * rg + e] = pn;
                float x = pn + quad_xor1(pn); x += quad_xor2(x); sm[e] = x; }
            *(LAS f32x4*)(PS + tl * PS_STRIDE + nb * 32 + 8 * rg + 4 * hi) = sm;
        }
    asm volatile("s_waitcnt lgkmcnt(0)" ::: "memory");
    f32x16 o[2];
    o[0] = (f32x16){0.f, 0.f, 0.f, 0.f, 0.f, 0.f, 0.f, 0.f, 0.f, 0.f, 0.f, 0.f, 0.f, 0.f, 0.f, 0.f}; o[1] = o[0];
#pragma unroll
    for (int nb = 0; nb < 4; ++nb) {
        if (nb <= nbmax) {
#pragma unroll
            for (int ks = 0; ks < 2; ++ks) {
                u32x4 pw; pw.x = cvt_pk_bf16(p[nb][8 * ks + 0], p[nb][8 * ks + 1]); pw.y = cvt_pk_bf16(p[nb][8 * ks + 2], p[nb][8 * ks + 3]);
                pw.z = cvt_pk_bf16(p[nb][8 * ks + 4], p[nb][8 * ks + 5]); pw.w = cvt_pk_bf16(p[nb][8 * ks + 6], p[nb][8 * ks + 7]);
                asm volatile("s_nop 1" : "+v"(pw));
                const bf16x8 pa = __builtin_bit_cast(bf16x8, pw);
#pragma unroll
                for (int d0 = 0; d0 < 2; ++d0) {
                    const bf16x8 vb = __builtin_bit_cast(bf16x8, (u32x4){vlo[nb][ks][d0].x, vlo[nb][ks][d0].y, vhh[nb][ks][d0].x, vhh[nb][ks][d0].y});
                    o[d0] = __builtin_amdgcn_mfma_f32_32x32x16_bf16(pa, vb, o[d0], 0, 0, 0);
                }
            }
        }
    }
    bf16_t* OC = (bf16_t*)(ws + WS_OCMP);
#pragma unroll
    for (int r = 0; r < 16; ++r) { const int q = crow(r, hi); const size_t orow = (size_t)b * SEQ + t0 + 8 * wid + (q >> 2); const int head = g * 4 + (q & 3);
        const float g0 = Gt[orow * 24 + head];
#pragma unroll
        for (int d0 = 0; d0 < 2; ++d0) OC[orow * 512 + head * 64 + d0 * 32 + r32] = (bf16_t)(cvt_pk_bf16(o[d0][r] * g0, 0.f) & 0xffffu); }
    {
        const int tk = lane & 7, blk = tt;
        float val[32];
        float prev_last = 0.f;
#pragma unroll
        for (int j = 0; j < 32; ++j) { const f32x4 x = *(const LAS f32x4*)(PS + tk * PS_STRIDE + 4 * j);
            const float imp = ((x[0] + x[1]) + (x[2] + x[3])) + prev_last; prev_last = x[3];
            val[j] = (j >= 1 && j <= blk - 2) ? imp : -INFINITY; }
        unsigned sel = 1u | (1u << blk) | (blk >= 1 ? (1u << (blk - 1)) : 0u);
#pragma unroll 1
        for (int round = 0; round < 5; ++round) {
            float best = -INFINITY; int bi = -1;
#pragma unroll
            for (int j = 0; j < 32; ++j) if (val[j] > best) { best = val[j]; bi = j; }
            if (bi >= 0) sel |= 1u << bi;
#pragma unroll
            for (int j = 0; j < 32; ++j) val[j] = (j == bi) ? -INFINITY : val[j];
        }
        if (lane < 8) ((unsigned*)(ws + WS_BM))[(size_t)plane * SEQ + t0 + 8 * wid + lane] = sel;
    }
    __syncthreads();
}

namespace fa {
constexpr int VSTR = 144, KCH = 1040, KBUF = 8 * KCH, VBUF = 64 * VSTR, OFF_V = 4 * KBUF, OFF_SCR = OFF_V + 4 * VBUF, OFF_STAGE = OFF_SCR + 2048;
__device__ __forceinline__ float bfi_f(unsigned msk, float a, float b) { return __uint_as_float((__float_as_uint(a) & msk) | (__float_as_uint(b) & ~msk)); }
template <int H>
__device__ __forceinline__ void load_k_half(const LAS unsigned char* kbuf, int r32, int hi, bf16x8 (&kf)[8]) {
    const LAS unsigned char* kb = kbuf + hi * KCH + r32 * 16;
#pragma unroll
    for (int d0 = 2 * H; d0 < 2 * H + 2; ++d0) { kf[2 * d0] = *(const LAS bf16x8*)(kb + d0 * 2 * KCH); kf[2 * d0 + 1] = *(const LAS bf16x8*)(kb + d0 * 2 * KCH + 512); }
}
__device__ __forceinline__ void load_k(const LAS unsigned char* kbuf, int r32, int hi, bf16x8 (&kf)[8]) {
    const LAS unsigned char* kb = kbuf + hi * KCH + r32 * 16;
#pragma unroll
    for (int d0 = 0; d0 < 4; ++d0) { kf[2 * d0] = *(const LAS bf16x8*)(kb + d0 * 2 * KCH); kf[2 * d0 + 1] = *(const LAS bf16x8*)(kb + d0 * 2 * KCH + 512); }
}
__device__ __forceinline__ void mma_qk(const bf16x8 (&kf)[8], const bf16x8 (&qr)[4], const f32x16& negm, f32x16& p0, f32x16& p1) {
    p0 = __builtin_amdgcn_mfma_f32_32x32x16_bf16(kf[0], qr[0], negm, 0, 0, 0); p1 = __builtin_amdgcn_mfma_f32_32x32x16_bf16(kf[1], qr[0], negm, 0, 0, 0);
#pragma unroll
    for (int d0 = 1; d0 < 4; ++d0) { p0 = __builtin_amdgcn_mfma_f32_32x32x16_bf16(kf[2 * d0], qr[d0], p0, 0, 0, 0); p1 = __builtin_amdgcn_mfma_f32_32x32x16_bf16(kf[2 * d0 + 1], qr[d0], p1, 0, 0, 0); }
}
__device__ __forceinline__ void load_v(const LAS unsigned char* vbuf, int r32, int hi, bf16x8 (&vf)[8]) {
    const LAS unsigned char* vb = vbuf + r32 * VSTR + hi * 16;
#pragma unroll
    for (int ks = 0; ks < 4; ++ks) { vf[2 * ks] = *(const LAS bf16x8*)(vb + ks * 32); vf[2 * ks + 1] = *(const LAS bf16x8*)(vb + 32 * VSTR + ks * 32); }
}
__device__ __forceinline__ void mma_pv(const bf16x8 (&vf)[8], const u32x4 (&pw)[4], f32x16& o0, f32x16& o1) {
#pragma unroll
    for (int ks = 0; ks < 4; ++ks) {
        const bf16x8 pa = __builtin_bit_cast(bf16x8, pw[ks]);
        o0 = __builtin_amdgcn_mfma_f32_32x32x16_bf16(pa, vf[2 * ks], o0, 0, 0, 0);
        o1 = __builtin_amdgcn_mfma_f32_32x32x16_bf16(pa, vf[2 * ks + 1], o1, 0, 0, 0);
    }
}
__device__ __forceinline__ void qk_mfma(const LAS unsigned char* kbuf, const bf16x8 (&qr)[4], const f32x16& negm, int r32, int hi, f32x16& p0, f32x16& p1) {
    bf16x8 kf[8]; load_k(kbuf, r32, hi, kf); mma_qk(kf, qr, negm, p0, p1);
}
__device__ __forceinline__ void pv_mfma(const LAS unsigned char* vbuf, const u32x4 (&pw)[4], int r32, int hi, f32x16& o0, f32x16& o1) {
    bf16x8 vf[8]; load_v(vbuf, r32, hi, vf); mma_pv(vf, pw, o0, o1);
}
template <int MODE>
__device__ __forceinline__ void apply_mask(int j, int j1, int t, int tw0, bool selj, u64 mbits, bool chk, int hi, f32x16& p0, f32x16& p1) {
    const int kv0 = j * 64, d = t - kv0;
    u64 w = mbits; bool need = true;
    if (MODE == 0) {
        const u64 low = (d >= 63) ? ~0ull : ((2ull << d) - 1ull);
        w = selj ? low : 0ull;
        need = (j == j1);
    } else if (MODE == 1) {
        const u64 low = (d >= 63) ? ~0ull : ((2ull << d) - 1ull);
        const int e = d - 512;
        const u64 high = (e < 0) ? ~0ull : ((e >= 63) ? 0ull : ~((2ull << e) - 1ull));
        w = low & high;
        need = !((kv0 + 63 <= tw0) && (kv0 > tw0 + 31 - 512));
    }
    if (need) {
        w >>= (4 * hi);
        const unsigned wl = (unsigned)w, wh = (unsigned)(w >> 32);
#pragma unroll
        for (int r = 0; r < 16; ++r) { const int pos = (r & 3) + 8 * (r >> 2);
            p0[r] = bfi_f((unsigned)__builtin_amdgcn_sbfe((int)wl, pos, 1), p0[r], NEGBIG);
            p1[r] = bfi_f((unsigned)__builtin_amdgcn_sbfe((int)wh, pos, 1), p1[r], NEGBIG); }
    }
}
template <bool ASM>
__device__ __forceinline__ float row_max_rel(const f32x16& p0, const f32x16& p1) {
    if (ASM) {
        float ra = max3f(p0[0], p0[1], p1[0]), rb = max3f(p0[2], p0[3], p1[1]);
        ra = max3f(ra, p1[2], p1[3]);
#pragma unroll
        for (int r = 4; r < 16; r += 4) { ra = max3f(ra, p0[r], p0[r + 1]); rb = max3f(rb, p0[r + 2], p0[r + 3]); ra = max3f(ra, p1[r], p1[r + 1]); rb = max3f(rb, p1[r + 2], p1[r + 3]); }
        float rm = max3f(ra, rb, 0.f);
        { auto rr = __builtin_amdgcn_permlane32_swap(__float_as_uint(rm), __float_as_uint(rm), false, false); rm = max3f(__uint_as_float(rr[0]), __uint_as_float(rr[1]), rm); }
        return rm;
    } else {
#define MX3(a, b, c) __builtin_fmaxf(__builtin_fmaxf((a), (b)), (c))
        float ra = MX3(p0[0], p0[1], p1[0]), rb = MX3(p0[2], p0[3], p1[1]);
        ra = MX3(ra, p1[2], p1[3]);
#pragma unroll
        for (int r = 4; r < 16; r += 4) { ra = MX3(ra, p0[r], p0[r + 1]); rb = MX3(rb, p0[r + 2], p0[r + 3]); ra = MX3(ra, p1[r], p1[r + 1]); rb = MX3(rb, p1[r + 2], p1[r + 3]); }
        float rm = MX3(ra, rb, 0.f);
        { auto rr = __builtin_amdgcn_permlane32_swap(__float_as_uint(rm), __float_as_uint(rm), false, false); rm = MX3(__uint_as_float(rr[0]), __uint_as_float(rr[1]), rm); }
#undef MX3
        return rm;
    }
}
__device__ __forceinline__ void move_reference(LAS float* scr, int r32, int hi, float rm, float& m, f32x16& negm, float& l, f32x16& o0, f32x16& o1) {
    m += rm;
#pragma unroll
    for (int r = 0; r < 16; ++r) negm[r] = -m;
    const float alpha = fast_exp2(-rm);
    l *= alpha;
    if (hi == 0) scr[r32] = alpha;
    asm volatile("s_waitcnt lgkmcnt(0)" ::: "memory");
#pragma unroll
    for (int r = 0; r < 16; ++r) { const float ar = scr[crow(r, hi)]; o0[r] *= ar; o1[r] *= ar; }
}
template <bool ASM>
__device__ __forceinline__ void range_check(LAS float* scr, int r32, int hi, f32x16& p0, f32x16& p1, float& m, f32x16& negm, float& l, f32x16& o0, f32x16& o1) {
    const float rm = row_max_rel<ASM>(p0, p1);
    if (__any(rm > 8.f)) {
#pragma unroll
        for (int r = 0; r < 16; ++r) { p0[r] -= rm; p1[r] -= rm; }
        move_reference(scr, r32, hi, rm, m, negm, l, o0, o1);
    }
}
__device__ __forceinline__ void exp_sum_pack(f32x16& p0, f32x16& p1, bool zero, u32x4 (&pw)[4], float& ls) {
    float s0 = 0.f, s1 = 0.f;
#pragma unroll
    for (int r = 0; r < 16; ++r) { p0[r] = fast_exp2(p0[r]); p1[r] = fast_exp2(p1[r]); s0 += p0[r]; s1 += p1[r]; }
    pw[0] = (u32x4){cvtpk_s(p0[0], p0[1]), cvtpk_s(p0[2], p0[3]), cvtpk_s(p0[4], p0[5]), cvtpk_s(p0[6], p0[7])};
    pw[1] = (u32x4){cvtpk_s(p0[8], p0[9]), cvtpk_s(p0[10], p0[11]), cvtpk_s(p0[12], p0[13]), cvtpk_s(p0[14], p0[15])};
    pw[2] = (u32x4){cvtpk_s(p1[0], p1[1]), cvtpk_s(p1[2], p1[3]), cvtpk_s(p1[4], p1[5]), cvtpk_s(p1[6], p1[7])};
    pw[3] = (u32x4){cvtpk_s(p1[8], p1[9]), cvtpk_s(p1[10], p1[11]), cvtpk_s(p1[12], p1[13]), cvtpk_s(p1[14], p1[15])};
    ls = s0 + s1;
    if (zero) { ls = 0.f;
#pragma unroll
        for (int q = 0; q < 4; ++q) pw[q] = (u32x4){0u, 0u, 0u, 0u}; }
}
template <int MODE>
__device__ __forceinline__ void tile_compute(LAS unsigned char* lds, int cur, int j, int j1, bool chk, const bf16x8 (&qr)[4], int t, int tw0, int tile_lim, unsigned bm, u64 mbits,
                                             LAS float* scr, int r32, int hi, float& m, f32x16& negm, float& l, f32x16& o0, f32x16& o1) {
    bool selj = true;
    if (MODE == 0) selj = (bm >> j) & 1u;
    const bool active = (MODE == 2) ? (j <= tile_lim) : true;
    if (!active) return;
    f32x16 p0, p1; u32x4 pw[4]; float ls;
    qk_mfma(lds + cur * KBUF, qr, negm, r32, hi, p0, p1);
    apply_mask<MODE>(j, j1, t, tw0, selj, mbits, chk, hi, p0, p1);
    if (chk) range_check<MODE == 2>(scr, r32, hi, p0, p1, m, negm, l, o0, o1);
    exp_sum_pack(p0, p1, (MODE == 0) && (j != j1) && !selj, pw, ls);
    l += ls;
    pv_mfma(lds + OFF_V + cur * VBUF, pw, r32, hi, o0, o1);
}
template <int MODE, class MidS, class MidL>
__device__ __forceinline__ void tile_pair(LAS unsigned char* lds, int cur, int ja, int j1, bool chk, const bf16x8 (&qr)[4], int t, int tw0, unsigned bm, u64 mbA, u64 mbB,
                                          LAS float* scr, int r32, int hi, float& m, f32x16& negm, float& l, f32x16& o0, f32x16& o1, const MidS& mid_store, const MidL& mid_load) {
    bool selA = true, selB = true;
    if (MODE == 0) { selA = (bm >> ja) & 1u; selB = (bm >> (ja + 1)) & 1u; }
    f32x16 a0, a1, b0, b1; u32x4 pwA[4], pwB[4]; float lsA, lsB;
    bf16x8 kfA[8], kfB[8], vfA[8], vfB[8];
    load_k(lds + cur * KBUF, r32, hi, kfA);
    mma_qk(kfA, qr, negm, a0, a1);
    __builtin_amdgcn_sched_group_barrier(0x100, 8, 0); __builtin_amdgcn_sched_group_barrier(0x008, 8, 0);
    load_k_half<0>(lds + (cur + 1) * KBUF, r32, hi, kfB);
    mid_store();
    apply_mask<MODE>(ja, j1, t, tw0, selA, mbA, chk, hi, a0, a1);
    float rm = 0.f;
    if (chk) rm = row_max_rel<MODE == 2>(a0, a1);
    load_k_half<1>(lds + (cur + 1) * KBUF, r32, hi, kfB);
    mma_qk(kfB, qr, negm, b0, b1);
    exp_sum_pack(a0, a1, (MODE == 0) && (ja != j1) && !selA, pwA, lsA);
#pragma unroll
    for (int g = 0; g < 4; ++g) { __builtin_amdgcn_sched_group_barrier(0x008, 1, 0); __builtin_amdgcn_sched_group_barrier(0x100, 1, 0); __builtin_amdgcn_sched_group_barrier(0x002, 12, 0); }
#pragma unroll
    for (int g = 0; g < 4; ++g) { __builtin_amdgcn_sched_group_barrier(0x008, 1, 0); __builtin_amdgcn_sched_group_barrier(0x002, 12, 0); }
    l += lsA;
    __builtin_amdgcn_sched_barrier(0);
    mid_load();
    load_v(lds + OFF_V + cur * VBUF, r32, hi, vfA);
    apply_mask<MODE>(ja + 1, j1, t, tw0, selB, mbB, false, hi, b0, b1);
    mma_pv(vfA, pwA, o0, o1);
    exp_sum_pack(b0, b1, (MODE == 0) && (ja + 1 != j1) && !selB, pwB, lsB);
#pragma unroll
    for (int g = 0; g < 8; ++g) { __builtin_amdgcn_sched_group_barrier(0x008, 1, 0); __builtin_amdgcn_sched_group_barrier(0x002, 12, 0); }
    l += lsB;
    load_v(lds + OFF_V + (cur + 1) * VBUF, r32, hi, vfB);
    mma_pv(vfB, pwB, o0, o1);
    __builtin_amdgcn_sched_group_barrier(0x100, 8, 0); __builtin_amdgcn_sched_group_barrier(0x008, 8, 0);
    if (chk && __any(rm > 8.f)) move_reference(scr, r32, hi, rm, m, negm, l, o0, o1);
}
template <int MODE, bool PRE = false>
__device__ __forceinline__ void flash_pass(LAS unsigned char* lds, const bf16_t* Kb, const bf16_t* Vt, int kvstride, int j0, int j1,
                                           const bf16x8 (&qr)[4], int t, int tw0, int tile_lim, unsigned bm, const u64* mrow, float& m, float& l, f32x16& o0, f32x16& o1) {
    f32x16 negm = (f32x16){0.f, 0.f, 0.f, 0.f, 0.f, 0.f, 0.f, 0.f, 0.f, 0.f, 0.f, 0.f, 0.f, 0.f, 0.f, 0.f};
    int tid_ = threadIdx.x; asm volatile("" : "+v"(tid_));
    const int tid = tid_, lane = tid & 63, wid = __builtin_amdgcn_readfirstlane(tid >> 6), r32 = lane & 31, hi = lane >> 5;
    const int skv = tid >> 3, sc = tid & 7;
    LAS float* scr = (LAS float*)(lds + OFF_SCR) + wid * 64;
    const bf16_t* kp = Kb + (size_t)skv * kvstride + sc * 8;
    const bf16_t* vp = Vt + tid * 8;
    const size_t kts = (size_t)64 * kvstride;
    LAS unsigned char* kdst = lds + sc * KCH + skv * 16;
    LAS unsigned char* vdst = lds + OFF_V + skv * VSTR + (sc >> 1) * 32 + (sc & 1) * 8;
    u32x4 kA, vA, kB, vB; u64 mbA = 0ull, mbB = 0ull;
#define FA_LOAD(ja_) do { const int ja__ = min((ja_), j1), jb__ = min((ja_) + 1, j1); \
        kA = *(const u32x4*)(kp + (size_t)ja__ * kts); vA = *(const u32x4*)(vp + (size_t)ja__ * 4096); kB = *(const u32x4*)(kp + (size_t)jb__ * kts); vB = *(const u32x4*)(vp + (size_t)jb__ * 4096); } while (0)
#define FA_STORE(slot_) do { LAS unsigned char* kd_ = kdst + (slot_) * 2 * KBUF; LAS unsigned char* vd_ = vdst + (slot_) * 2 * VBUF; \
        *(LAS u32x4*)kd_ = kA; *(LAS u32x4*)(kd_ + KBUF) = kB; \
        *(LAS u32x2*)vd_ = (u32x2){vA.x, vA.y}; *(LAS u32x2*)(vd_ + 16) = (u32x2){vA.z, vA.w}; *(LAS u32x2*)(vd_ + VBUF) = (u32x2){vB.x, vB.y}; *(LAS u32x2*)(vd_ + VBUF + 16) = (u32x2){vB.z, vB.w}; } while (0)
    FA_LOAD(j0);
    if (MODE == 2) { mbA = mrow[j0]; mbB = mrow[min(j0 + 1, j1)]; }
    __syncthreads();
    FA_STORE(0);
    FA_LOAD(j0 + 2);
    __syncthreads();
    const int nt = j1 - j0 + 1;
    const int nfull = (MODE == 2) ? min((tile_lim - j0 + 1) >> 1, nt >> 1) : (nt >> 1);
    int ja = j0, slot = 0, step = 0;
#pragma unroll 1
    for (; step < nfull; ++step, ja += 2, slot ^= 1) {
        const u64 mcA = mbA, mcB = mbB;
        if (MODE == 2) { mbA = mrow[min(ja + 2, j1)]; mbB = mrow[min(ja + 3, j1)]; }
        tile_pair<MODE>(lds, 2 * slot, ja, j1, (step & 1) == 0, qr, t, tw0, bm, mcA, mcB, scr, r32, hi, m, negm, l, o0, o1,
                        [&]() { if (ja + 2 <= j1) FA_STORE(slot ^ 1); }, [&]() { FA_LOAD(ja + 4); });
        __syncthreads();
    }
#pragma unroll 1
    for (; ja <= j1; ++step, ja += 2, slot ^= 1) {
        const u64 mcA = mbA, mcB = mbB;
        if (MODE == 2) { mbA = mrow[min(ja + 2, j1)]; mbB = mrow[min(ja + 3, j1)]; }
        if (ja + 2 <= j1) FA_STORE(slot ^ 1);
        FA_LOAD(ja + 4);
        tile_compute<MODE>(lds, 2 * slot, ja, j1, (step & 1) == 0, qr, t, tw0, tile_lim, bm, mcA, scr, r32, hi, m, negm, l, o0, o1);
        if (ja + 1 <= j1) tile_compute<MODE>(lds, 2 * slot + 1, ja + 1, j1, false, qr, t, tw0, tile_lim, bm, mcB, scr, r32, hi, m, negm, l, o0, o1);
        __syncthreads();
    }
#undef FA_LOAD
#undef FA_STORE
}
__device__ __forceinline__ void row_factors(LAS unsigned char* lds, float f, float (&fr)[16]) {
    const int lane = threadIdx.x & 63, wid = __builtin_amdgcn_readfirstlane(threadIdx.x >> 6), r32 = lane & 31, hi = lane >> 5;
    LAS float* scr = (LAS float*)(lds + OFF_SCR) + wid * 64 + 32;
    if (hi == 0) scr[r32] = f;
    asm volatile("s_waitcnt lgkmcnt(0)" ::: "memory");
#pragma unroll
    for (int r = 0; r < 16; ++r) fr[r] = scr[crow(r, hi)];
    asm volatile("s_waitcnt lgkmcnt(0)" ::: "memory");
}
__device__ __forceinline__ void nsa_unit(const Args& a, LAS unsigned char* lds, int plane, int blk) {
    unsigned char* ws = a.ws;
    const int tid = threadIdx.x, lane = tid & 63, wid = __builtin_amdgcn_readfirstlane(tid >> 6), r32 = lane & 31, hi = lane >> 5;
    const int b = plane >> 1, g = plane & 1, t0 = blk * 64, hd = wid & 3, head = g * 4 + hd;
    const int tw0 = t0 + 32 * (wid >> 2), t = tw0 + r32;
    const size_t trow = (size_t)b * SEQ + t;
    const bf16_t* Qn = (const bf16_t*)(ws + WS_QN) + trow * 512 + head * 64;
    bf16x8 qr[4];
#pragma unroll
    for (int d0 = 0; d0 < 4; ++d0) qr[d0] = *(const bf16x8*)(Qn + d0 * 16 + hi * 8);
    const unsigned bm = ((const unsigned*)(ws + WS_BM))[(size_t)plane * SEQ + t];
    const float* Gt = (const float*)(ws + WS_GT) + trow * 24;
    const float g1 = Gt[8 + head], g2 = Gt[16 + head];
    const size_t pbase = (size_t)plane * SEQ * 64;
    const f32x16 z = (f32x16){0.f, 0.f, 0.f, 0.f, 0.f, 0.f, 0.f, 0.f, 0.f, 0.f, 0.f, 0.f, 0.f, 0.f, 0.f, 0.f};
    LAS float* stage = (LAS float*)(lds + OFF_STAGE) + wid * 2048 + lane;
    f32x16 res0, res1;
    {
        float m = 0.f, l = 0.f; f32x16 o0 = z, o1 = z;
        flash_pass<0>(lds, (const bf16_t*)(ws + WS_KCR + 2 * PLANE_BUF) + pbase, (const bf16_t*)(ws + WS_KCR + 3 * PLANE_BUF) + pbase, 64, 0, blk, qr, t, tw0, 0, bm, nullptr, m, l, o0, o1);
        const float f = g1 / swap_sum(l); float fr[16]; row_factors(lds, f, fr);
#pragma unroll
        for (int r = 0; r < 16; ++r) { stage[(2 * r) * 64] = o0[r] * fr[r]; stage[(2 * r + 1) * 64] = o1[r] * fr[r]; }
    }
    {
        float m = 0.f, l = 0.f; f32x16 o0 = z, o1 = z;
        const int j0 = blk >= 8 ? blk - 8 : 0;
        flash_pass<1>(lds, (const bf16_t*)(ws + WS_KCR + 4 * PLANE_BUF) + pbase, (const bf16_t*)(ws + WS_KCR + 5 * PLANE_BUF) + pbase, 64, j0, blk, qr, t, tw0, 0, 0u, nullptr, m, l, o0, o1);
        const float f = g2 / swap_sum(l); float fr[16]; row_factors(lds, f, fr);
#pragma unroll
        for (int r = 0; r < 16; ++r) { res0[r] = o0[r] * fr[r] + stage[(2 * r) * 64]; res1[r] = o1[r] * fr[r] + stage[(2 * r + 1) * 64]; }
    }
    const bf16_t* OC = (const bf16_t*)(ws + WS_OCMP);
    bf16_t* AO = (bf16_t*)(ws + WS_AO);
    int hio = hi, r32o = r32; asm volatile("" : "+v"(hio), "+v"(r32o));
    bf16_t c0[16], c1[16];
#pragma unroll
    for (int r = 0; r < 16; ++r) { const size_t orow = (size_t)b * SEQ + t0 + 32 * (wid >> 2) + crow(r, hio);
        c0[r] = OC[orow * 512 + head * 64 + r32o]; c1[r] = OC[orow * 512 + head * 64 + 32 + r32o]; }
#pragma unroll
    for (int r = 0; r < 16; ++r) { const size_t orow = (size_t)b * SEQ + t0 + 32 * (wid >> 2) + crow(r, hio);
        AO[orow * DM + head * 64 + r32o] = (bf16_t)(cvt_pk_bf16(res0[r] + bf2f(c0[r]), 0.f) & 0xffffu);
        AO[orow * DM + head * 64 + 32 + r32o] = (bf16_t)(cvt_pk_bf16(res1[r] + bf2f(c1[r]), 0.f) & 0xffffu); }
}
__device__ __forceinline__ void dsa_unit(const Args& a, LAS unsigned char* lds, int b, int h, int qb) {
    unsigned char* ws = a.ws;
    int tid_ = threadIdx.x; asm volatile("" : "+v"(tid_));
    const int tid = tid_, lane = tid & 63, wid = __builtin_amdgcn_readfirstlane(tid >> 6), r32 = lane & 31, hi = lane >> 5;
    const int t0 = qb * 256, t = t0 + 32 * wid + r32;
    const size_t trow = (size_t)b * SEQ + t;
    const bf16_t* Qd = (const bf16_t*)(ws + WS_QD) + trow * 512 + h * 64;
    bf16x8 qr[4];
#pragma unroll
    for (int d0 = 0; d0 < 4; ++d0) qr[d0] = *(const bf16x8*)(Qd + d0 * 16 + hi * 8);
    const u64* mrow = (const u64*)(ws + WS_MASKD) + trow * 32;
    const f32x16 z = (f32x16){0.f, 0.f, 0.f, 0.f, 0.f, 0.f, 0.f, 0.f, 0.f, 0.f, 0.f, 0.f, 0.f, 0.f, 0.f, 0.f};
    float m = 0.f, l = 0.f; f32x16 o0 = z, o1 = z;
    const size_t kbase = (size_t)b * SEQ * 512 + h * 64;
    flash_pass<2>(lds, (const bf16_t*)(ws + WS_KD) + kbase, (const bf16_t*)(ws + WS_VD) + (size_t)(b * 8 + h) * 32 * 4096, 512, 0, 4 * qb + 3, qr, t, t0 + 32 * wid, 4 * qb + (wid >> 1), 0u, mrow, m, l, o0, o1);
    const float f = 1.0f / swap_sum(l); float fr[16]; row_factors(lds, f, fr);
    bf16_t* AO = (bf16_t*)(ws + WS_AO);
    int hio = hi, r32o = r32; asm volatile("" : "+v"(hio), "+v"(r32o));
#pragma unroll
    for (int r = 0; r < 16; ++r) { const size_t orow = (size_t)b * SEQ + t0 + 32 * wid + crow(r, hio);
        AO[orow * DM + 512 + h * 64 + r32o] = (bf16_t)(cvt_pk_bf16(o0[r] * fr[r], 0.f) & 0xffffu);
        AO[orow * DM + 512 + h * 64 + 32 + r32o] = (bf16_t)(cvt_pk_bf16(o1[r] * fr[r], 0.f) & 0xffffu); }
}
}

__device__ __forceinline__ void p7_mid(const Args& a) {
    unsigned char* ws = a.ws; const float* mod = (const float*)(ws + WS_MOD);
    const int lane = threadIdx.x & 63, gw = blockIdx.x * 8 + (threadIdx.x >> 6), NGW = gridDim.x * 8;
    f32x4 xv[2][4], xn[2][4]; u32x2 yv[2][4], yn[2][4]; float sv[2], sn[2];
#define P7_LOAD(X, Y, S, row) do { const f32x4* xr_ = (const f32x4*)(a.in[I_X] + (size_t)(row) * DM) + lane; const u32x2* yr_ = (const u32x2*)((const bf16_t*)(ws + WS_Y) + (size_t)(row) * DM) + lane; \
        _Pragma("unroll") for (int j = 0; j < 4; ++j) { X[j] = __builtin_nontemporal_load(xr_ + 64 * j); Y[j] = yr_[64 * j]; } S = (lane < 32) ? ((const float*)(ws + WS_SSQY))[(size_t)(row) * 32 + lane] : 0.f; } while (0)
#pragma unroll
    for (int u = 0; u < 2; ++u) { const int row = min(gw + u * NGW, MTOK - 1); P7_LOAD(xv[u], yv[u], sv[u], row); }
#pragma unroll 1
    for (int row0 = gw; row0 < MTOK; row0 += 2 * NGW) {
#pragma unroll
        for (int u = 0; u < 2; ++u) { const int row = min(row0 + (2 + u) * NGW, MTOK - 1); P7_LOAD(xn[u], yn[u], sn[u], row); }
#pragma unroll
        for (int u = 0; u < 2; ++u) {
            const int row = row0 + u * NGW;
            if (row < MTOK) {
                const int b = row >> 11;
                const float rstd_y = 1.0f / sqrtf(wave_sum(sv[u]) * (1.f / DM) + EPS);
                f32x4 x1[4]; float s2 = 0.f;
#pragma unroll
                for (int j = 0; j < 4; ++j) { const int c = 256 * j + 4 * lane;
                    const f32x4 gq = *(const f32x4*)(a.in[I_GQM] + c), ga = *(const f32x4*)(mod + (size_t)b * 6144 + 2048 + c);
                    const float yf[4] = {bflo(yv[u][j].x), bfhi(yv[u][j].x), bflo(yv[u][j].y), bfhi(yv[u][j].y)};
#pragma unroll
                    for (int e = 0; e < 4; ++e) { x1[j][e] = xv[u][j][e] + ga[e] * (yf[e] * rstd_y * gq[e]); s2 += x1[j][e] * x1[j][e]; }
                    }
                const float rstd = 1.0f / sqrtf(wave_sum(s2) * (1.f / DM) + EPS);
                u32x2* o = (u32x2*)((bf16_t*)(ws + WS_H) + (size_t)row * DM) + lane;
#pragma unroll
                for (int j = 0; j < 4; ++j) { const int c = 256 * j + 4 * lane;
                    const f32x4 g = *(const f32x4*)(a.in[I_GPF] + c), sh = *(const f32x4*)(mod + (size_t)b * 6144 + 3072 + c), sc = *(const f32x4*)(mod + (size_t)b * 6144 + 4096 + c);
                    float h[4];
#pragma unroll
                    for (int e = 0; e < 4; ++e) h[e] = (x1[j][e] * rstd * g[e]) * (1.f + sc[e]) + sh[e];
                    o[64 * j] = (u32x2){cvt_pk_bf16(h[0], h[1]), cvt_pk_bf16(h[2], h[3])}; }
            }
        }
#pragma unroll
        for (int u = 0; u < 2; ++u) { sv[u] = sn[u];
#pragma unroll
            for (int j = 0; j < 4; ++j) { xv[u][j] = xn[u][j]; yv[u][j] = yn[u][j]; } }
    }
#undef P7_LOAD
}
__device__ __forceinline__ void p10_final(const Args& a) {
    unsigned char* ws = a.ws; const float* mod = (const float*)(ws + WS_MOD);
    const int lane = threadIdx.x & 63, gw = blockIdx.x * 8 + (threadIdx.x >> 6), NGW = gridDim.x * 8;
    f32x4 xv[2][4], xn[2][4]; u32x2 yv[2][4], yn[2][4], zv[2][4], zn[2][4]; float sy[2], syn[2], sz[2], szn[2];
#define P10_LOAD(X, Y, Z, SY, SZ, row) do { const f32x4* xr_ = (const f32x4*)(a.in[I_X] + (size_t)(row) * DM) + lane; const u32x2* yr_ = (const u32x2*)((const bf16_t*)(ws + WS_Y) + (size_t)(row) * DM) + lane; \
        const u32x2* zr_ = (const u32x2*)((const bf16_t*)(ws + WS_Z) + (size_t)(row) * DM) + lane; \
        _Pragma("unroll") for (int j = 0; j < 4; ++j) { X[j] = __builtin_nontemporal_load(xr_ + 64 * j); Y[j] = yr_[64 * j]; Z[j] = zr_[64 * j]; } \
        SY = (lane < 32) ? ((const float*)(ws + WS_SSQY))[(size_t)(row) * 32 + lane] : 0.f; SZ = (lane < 32) ? ((const float*)(ws + WS_SSQZ))[(size_t)(row) * 32 + lane] : 0.f; } while (0)
#pragma unroll
    for (int u = 0; u < 2; ++u) { const int row = min(gw + u * NGW, MTOK - 1); P10_LOAD(xv[u], yv[u], zv[u], sy[u], sz[u], row); }
#pragma unroll 1
    for (int row0 = gw; row0 < MTOK; row0 += 2 * NGW) {
#pragma unroll
        for (int u = 0; u < 2; ++u) { const int row = min(row0 + (2 + u) * NGW, MTOK - 1); P10_LOAD(xn[u], yn[u], zn[u], syn[u], szn[u], row); }
#pragma unroll
        for (int u = 0; u < 2; ++u) {
            const int row = row0 + u * NGW;
            if (row < MTOK) {
                const int b = row >> 11;
                const float rstd_y = 1.0f / sqrtf(wave_sum(sy[u]) * (1.f / DM) + EPS);
                const float rstd_z = 1.0f / sqrtf(wave_sum(sz[u]) * (1.f / DM) + EPS);
                f32x4* orow = (f32x4*)(a.out + (size_t)row * DM) + lane;
#pragma unroll
                for (int j = 0; j < 4; ++j) { const int c = 256 * j + 4 * lane;
                    const f32x4 gq = *(const f32x4*)(a.in[I_GQM] + c), ga = *(const f32x4*)(mod + (size_t)b * 6144 + 2048 + c);
                    const f32x4 gqf = *(const f32x4*)(a.in[I_GQF] + c), gaf = *(const f32x4*)(mod + (size_t)b * 6144 + 5120 + c);
                    const float yf[4] = {bflo(yv[u][j].x), bfhi(yv[u][j].x), bflo(yv[u][j].y), bfhi(yv[u][j].y)};
                    const float zf[4] = {bflo(zv[u][j].x), bfhi(zv[u][j].x), bflo(zv[u][j].y), bfhi(zv[u][j].y)};
                    f32x4 xo;
#pragma unroll
                    for (int e = 0; e < 4; ++e) { const float x1 = xv[u][j][e] + ga[e] * (yf[e] * rstd_y * gq[e]); xo[e] = x1 + gaf[e] * (zf[e] * rstd_z * gqf[e]); }
                    orow[64 * j] = xo; }
            }
        }
#pragma unroll
        for (int u = 0; u < 2; ++u) { sy[u] = syn[u]; sz[u] = szn[u];
#pragma unroll
            for (int j = 0; j < 4; ++j) { xv[u][j] = xn[u][j]; yv[u][j] = yn[u][j]; zv[u][j] = zn[u][j]; } }
    }
#undef P10_LOAD
}

__device__ __forceinline__ int queue_next(unsigned* head, volatile LAS unsigned* slot) {
    if (threadIdx.x == 0) *slot = __hip_atomic_fetch_add(head, 1u, __ATOMIC_RELAXED, __HIP_MEMORY_SCOPE_AGENT);
    __syncthreads();
    const int u = (int)*slot;
    __syncthreads();
    return u;
}

#ifndef MK_NVGPR
#define MK_NVGPR 256
#endif
__global__ void __launch_bounds__(512, 2) __attribute__((amdgpu_num_vgpr(MK_NVGPR))) mk_fwd(Args args) {
    extern __shared__ __attribute__((aligned(16))) unsigned char lds_raw[];
    LAS unsigned char* lds = (LAS unsigned char*)lds_raw;
    volatile LAS unsigned* MISC = (volatile LAS unsigned*)(lds + MISC_OFF);
    const int tid = threadIdx.x, G = gridDim.x, blk = blockIdx.x;
    unsigned char* ws = args.ws;
    unsigned* ctl = (unsigned*)(ws + WS_CTL);
    if (tid < 64) MISC[tid] = 0u;
    __syncthreads();
    XcdBarrier bar; bar.bar = ctl + CW_BAR + args.li * XCD_BAR_WORDS; bar.x = 0; bar.st = nullptr;
    if (MK_N_LAUNCHES != NPH) bar = xcd_barrier_post(ctl + CW_BAR + args.li * XCD_BAR_WORDS, MISC + 8);
    const int lo = args.ph_lo, hi = args.ph_hi;
#ifndef MK_PHASE_MASK
#define MK_PHASE_MASK 0xffffu
#endif
#ifndef MK_REPEAT_MASK
#define MK_REPEAT_MASK 0u
#endif
#define REP(k) for (int rep_ = 0; rep_ < (((MK_REPEAT_MASK >> (k)) & 1u) ? 2 : 1); ++rep_)
#define IN(k) ((MK_PHASE_MASK >> (k)) & 1u) && (lo <= (k) && (k) < hi)
#define SEAM(k) do { if (IN(k) && IN((k) + 1)) xcd_barrier(bar); } while (0)

    if (IN(0)) { REP(0) p0_prologue(args, lds); } SEAM(0);
    if (IN(1)) { REP(1) p1_hnorm(args); } SEAM(1);
    if (IN(2)) REP(2) {
        pg8::Gemm g{(const bf16_t*)(ws + WS_H), (const bf16_t*)(ws + WS_WIN), MTOK, NPROJ, DM, DM}; pg8::StaticOrder S; S.init(MTOK, NPROJ, G, blk);
        pg8::EpiInProj E{ws};
        pg8::gemm_phase<pg8::EpiInProj, pg8::StaticOrder, true>(lds, g, S, E);
    } SEAM(2);
    if (IN(3)) {
#ifndef MK_P3
#define MK_P3 7
#endif
        REP(11) {
        if ((MK_P3 & 1) && blk < 32) {
            const int kv = blk >> 4, pm = blk & 15;
            { pg8::Gemm g{(const bf16_t*)(ws + WS_KCR + (size_t)kv * PLANE_BUF), (const bf16_t*)(ws + WS_WC1) + (size_t)kv * 256 * 2048, 4096, 256, 2048, 1024};
              pg8::OneUnit S{pm, true}; pg8::EpiHid E{(bf16_t*)(ws + WS_HID) + (size_t)kv * 4096 * 256, (const float*)(ws + WS_B1P) + kv * 256};
              pg8::gemm_phase<pg8::EpiHid, pg8::OneUnit, false>(lds, g, S, E); }
            __builtin_amdgcn_fence(__ATOMIC_ACQUIRE, "agent"); asm volatile("s_waitcnt vmcnt(0)" ::: "memory"); __syncthreads();
            { pg8::Gemm g{(const bf16_t*)(ws + WS_HID) + (size_t)kv * 4096 * 256, (const bf16_t*)(ws + WS_WC2) + (size_t)kv * 256 * 256, 4096, 256, 256, 256};
              pg8::OneUnit S{pm, true}; pg8::EpiCmp E{ws, args.in[I_CB2] + kv * 64, kv};
              pg8::gemm_phase<pg8::EpiCmp, pg8::OneUnit, false>(lds, g, S, E); }
        }
        if (MK_P3 & 2) { pg8::Gemm g{(const bf16_t*)(ws + WS_CRAW), (const bf16_t*)(ws + WS_WKV), MTOK, 1024, 256, 256}; pg8::StaticOrder S; S.init(MTOK, 1024, G, blk);
          pg8::EpiKvGen E{ws};
          pg8::gemm_phase<pg8::EpiKvGen, pg8::StaticOrder, true>(lds, g, S, E); }
        }
        if (MK_P3 & 4) REP(3) for (;;) { const int u = queue_next(ctl + CW_Q_IDX + 256 * rep_, MISC + 4); if (u >= 2048) break; idx_unit(args, lds, u & 15, 127 - (u >> 4)); }
    } SEAM(3);
    if (IN(4)) {
        REP(4) {
            int cur_plane = -1;
            for (int u = blk; u < 1024; u += G) {
                const int plane = u & 31;
                if (plane != cur_plane) {
                    cur_plane = plane;
                    const bf16_t* KCg = (const bf16_t*)(ws + WS_KC) + (size_t)plane * 128 * 64;
                    const bf16_t* VTg = (const bf16_t*)(ws + WS_VCT) + (size_t)plane * 64 * 128;
                    __syncthreads();
                    for (int c = tid; c < 1024; c += 512) { const int n = c >> 3, ch = c & 7; *(LAS u32x4*)(lds + CMP_KC_OFF + n * CMP_KC_STR + ch * 16) = *(const u32x4*)(KCg + n * 64 + ch * 8); }
                    for (int c = tid; c < 1024; c += 512) { const int dd = c >> 4, ch = c & 15; const u32x4 v = *(const u32x4*)(VTg + dd * 128 + ch * 8);
                        LAS unsigned char* q = lds + CMP_VT_OFF + dd * CMP_VT_STR + ch * 16; *(LAS u32x2*)q = (u32x2){v.x, v.y}; *(LAS u32x2*)(q + 8) = (u32x2){v.z, v.w}; }
                    __syncthreads();
                }
                cmp_unit(args, lds, plane, u >> 5);
            }
        }
    } SEAM(4);
    if (IN(5)) {
        if (threadIdx.x >= 256) __builtin_amdgcn_s_setprio(1);
        REP(5) for (;;) { const int u = queue_next(ctl + CW_Q_FLASH + 256 * rep_, MISC + 4); if (u >= 2048) break;
            const int qb = 7 - (u >> 8), v = u & 255;
            if (v >= 32 && v < 160) { const int w = v - 32; fa::dsa_unit(args, lds, w >> 3, w & 7, qb); }
            else { const int s4 = (v < 32) ? 0 : ((v - 128) >> 5);
                   fa::nsa_unit(args, lds, v & 31, 4 * qb + 3 - s4); }
        }
        __builtin_amdgcn_s_setprio(0);
    } SEAM(5);
    if (IN(6)) REP(6) {
        pg8::Gemm g{(const bf16_t*)(ws + WS_AO), (const bf16_t*)(ws + WS_WOUT), MTOK, DM, DM, DM}; pg8::StaticOrder S; S.init(MTOK, DM, G, blk);
        pg8::EpiY E{(bf16_t*)(ws + WS_Y), (float*)(ws + WS_SSQY)};
        pg8::gemm_phase<pg8::EpiY, pg8::StaticOrder, true>(lds, g, S, E);
    } SEAM(6);
    if (IN(7)) { REP(7) p7_mid(args); } SEAM(7);
    if (IN(8)) REP(8) {
        pg8::Gemm g{(const bf16_t*)(ws + WS_H), (const bf16_t*)(ws + WS_WGU), MTOK, NGU, DM, DM}; pg8::StaticOrder S; S.init(MTOK, NGU, G, blk);
        pg8::EpiSwiglu E{(bf16_t*)(ws + WS_ACT)};
        pg8::gemm_phase<pg8::EpiSwiglu, pg8::StaticOrder, true>(lds, g, S, E);
    } SEAM(8);
    if (IN(9)) REP(9) {
        pg8::Gemm g{(const bf16_t*)(ws + WS_ACT), (const bf16_t*)(ws + WS_WDN), MTOK, DM, DFF, DFF}; pg8::StaticOrder S; S.init(MTOK, DM, G, blk);
        pg8::EpiY E{(bf16_t*)(ws + WS_Z), (float*)(ws + WS_SSQZ)};
        pg8::gemm_phase<pg8::EpiY, pg8::StaticOrder, true>(lds, g, S, E);
    } SEAM(9);
    if (IN(10)) { p10_final(args); }
#undef IN
#undef SEAM
}

extern "C" void kernel_launch(void* const* d_in, const int* in_sizes, int n_in, void* d_out, int out_size, void* d_ws, size_t ws_size, hipStream_t stream) {
    static int grid = 0;
    if (grid == 0) {
        if (n_in != 20 || in_sizes[0] != MTOK * DM || out_size != MTOK * DM || ws_size < WS_END) {
            fprintf(stderr, "kernel_launch: unexpected shapes (n_in %d, in0 %d, out %d, ws %zu; need ws >= %zu); nothing launched\n", n_in, n_in > 0 ? in_sizes[0] : -1, out_size, ws_size, (size_t)WS_END); grid = -1; return; }
        int dev = 0, cus = 0, per_cu = 0;
        if (hipGetDevice(&dev) != hipSuccess || hipDeviceGetAttribute(&cus, hipDeviceAttributeMultiprocessorCount, dev) != hipSuccess) { fprintf(stderr, "kernel_launch: device query failed\n"); grid = -1; return; }
        if (hipFuncSetAttribute((const void*)mk_fwd, hipFuncAttributeMaxDynamicSharedMemorySize, LDS_BYTES) != hipSuccess) { fprintf(stderr, "kernel_launch: hipFuncSetAttribute failed\n"); grid = -1; return; }
        if (hipOccupancyMaxActiveBlocksPerMultiprocessor(&per_cu, (const void*)mk_fwd, 512, LDS_BYTES) != hipSuccess || per_cu < 1)
            fprintf(stderr, "kernel_launch: note: occupancy query reports %d workgroups per CU\n", per_cu);
        (void)hipGetLastError();
        grid = cus;
    }
    if (grid < 0) return;
    if (hipMemsetAsync((char*)d_ws + WS_CTL, 0, CTL_ZERO_BYTES, stream) != hipSuccess) { fprintf(stderr, "kernel_launch: memset failed\n"); return; }
    Args a{};
    for (int i = 0; i < 20; ++i) a.in[i] = (const float*)d_in[i];
    a.out = (float*)d_out; a.ws = (unsigned char*)d_ws; a.pad = 0;
#if MK_N_LAUNCHES == 1
    a.ph_lo = 0; a.ph_hi = NPH; a.li = 0;
    hipLaunchKernelGGL(mk_fwd, dim3(grid), dim3(512), LDS_BYTES, stream, a);
#else
#ifndef MK_HOST_REP
#define MK_HOST_REP -1
#endif
    for (int li = 0; li < NPH; ++li) { a.ph_lo = li; a.ph_hi = li + 1; a.li = 0; hipLaunchKernelGGL(mk_fwd, dim3(grid), dim3(512), LDS_BYTES, stream, a);
        if (li == MK_HOST_REP) hipLaunchKernelGGL(mk_fwd, dim3(grid), dim3(512), LDS_BYTES, stream, a); }
#endif
    const hipError_t le = hipPeekAtLastError();
    if (le != hipSuccess) fprintf(stderr, "kernel_launch: launch failed: %s\n", hipGetErrorName(le));
}
```
